# Optimizing an MI355X kernel written in HIP

```python
import jax, jax.numpy as jnp
from jax import lax
import numpy as np

D_MODEL = 2048
BATCH = 1
SEQ = 16384
DEPTH = 1

D_PLE = 256
D_MIX = D_MODEL
RW_HEAD_DIM = 64
RW_WIDTH = D_MIX // 2
RW_HEADS = RW_WIDTH // RW_HEAD_DIM
DECAY_LORA = 64
AAA_LORA = 64
FX_HEAD_DIM = 64
FX_WIDTH = D_MIX - RW_WIDTH
FX_HEADS = FX_WIDTH // FX_HEAD_DIM
Q_BLOCK = 128
RMS_EPS = 1e-6
GN_EPS = 64e-5
_SPLIT_SIZES = (RW_WIDTH, RW_WIDTH, RW_WIDTH, RW_WIDTH, DECAY_LORA, AAA_LORA,
                FX_WIDTH, FX_WIDTH, FX_WIDTH, FX_WIDTH, FX_HEADS)
IN_COLS = sum(_SPLIT_SIZES)

kernel_name = "hybrid_rwkv7_fox_parallel_heads"


def _split_offsets():
    offs, acc = [], 0
    for s in _SPLIT_SIZES[:-1]:
        acc += s
        offs.append(acc)
    return offs


def rms_norm(x, g, eps=RMS_EPS):
    xf = x.astype(jnp.float32)
    y = xf * lax.rsqrt(jnp.mean(xf * xf, axis=-1, keepdims=True) + eps)
    return (y * g.astype(jnp.float32)).astype(x.dtype)


def token_shift(z, mu):
    z_prev = jnp.pad(z, ((0, 0), (1, 0), (0, 0)))[:, :-1]
    return z + (z_prev - z) * mu


def rwkv7_scan(r, decay, k, v, a_vec, b_vec):
    B, T, H, N = r.shape

    def step(S, inp):
        r_t, w_t, k_t, v_t, a_t, b_t = inp
        sa = jnp.einsum('bhvk,bhk->bhv', S, a_t)
        S = (S * w_t[:, :, None, :] + sa[..., None] * b_t[:, :, None, :]
             + v_t[..., None] * k_t[:, :, None, :])
        y = jnp.einsum('bhvk,bhk->bhv', S, r_t)
        return S, y

    xs = tuple(jnp.moveaxis(t, 1, 0) for t in (r, decay, k, v, a_vec, b_vec))
    S0 = jnp.zeros((B, H, N, N), jnp.float32)
    _, ys = lax.scan(step, S0, xs)
    return jnp.moveaxis(ys, 0, 1)


def rwkv7_branch(zr, zk, zv, zw, za, mu_r, mu_k, mu_v, mu_w, mu_a,
                 w0, w2, a0, a2, k_k, k_a, r_k, ln_w, ln_b):
    B, T, C = zr.shape
    H, N = RW_HEADS, RW_HEAD_DIM
    f32 = jnp.float32
    r = token_shift(zr, mu_r).astype(f32)
    k = token_shift(zk, mu_k).astype(f32)
    v = token_shift(zv, mu_v).astype(f32)
    dw = token_shift(zw, mu_w)
    da = token_shift(za, mu_a)
    w_log = -jax.nn.softplus(-(w0 + jnp.tanh(dw) @ w2).astype(f32)) - 0.5
    decay = jnp.exp(-jnp.exp(w_log))
    a = jax.nn.sigmoid((a0 + da @ a2).astype(f32))
    kk = (k * k_k.astype(f32)).reshape(B, T, H, N)
    kk = kk / jnp.maximum(jnp.linalg.norm(kk, axis=-1, keepdims=True), 1e-12)
    k = k * (1.0 + (a - 1.0) * k_a.astype(f32))
    hv = lambda t: t.reshape(B, T, H, N)
    r4, k4, v4, a4, d4 = hv(r), hv(k), hv(v), hv(a), hv(decay)
    y = rwkv7_scan(r4, d4, k4, v4, -kk, kk * a4)
    mean = jnp.mean(y, axis=-1, keepdims=True)
    var = jnp.var(y, axis=-1, keepdims=True)
    y = ((y - mean) * lax.rsqrt(var + GN_EPS)).reshape(B, T, C)
    y = y * ln_w.astype(f32) + ln_b.astype(f32)
    bonus = jnp.sum(r4 * k4 * r_k.astype(f32), axis=-1, keepdims=True) * v4
    return (y + bonus.reshape(B, T, C)).astype(zr.dtype)


def forgetting_attention(q, k, v, f_logit, b_f, q_g, k_g):
    B, T, _ = q.shape
    H, Dh = FX_HEADS, FX_HEAD_DIM
    f32 = jnp.float32
    q = rms_norm(q.reshape(B, T, H, Dh), q_g).astype(f32).transpose(0, 2, 1, 3)
    k = rms_norm(k.reshape(B, T, H, Dh), k_g).astype(f32).transpose(0, 2, 1, 3)
    v = v.reshape(B, T, H, Dh).astype(f32).transpose(0, 2, 1, 3)
    log_f = jax.nn.log_sigmoid((f_logit + b_f).astype(f32))
    F = jnp.cumsum(log_f, axis=1).transpose(0, 2, 1)
    scale = Dh ** -0.5
    k_pos = jnp.arange(T)

    def block(i):
        start = i * Q_BLOCK
        qb = lax.dynamic_slice_in_dim(q, start, Q_BLOCK, axis=2)
        Fq = lax.dynamic_slice_in_dim(F, start, Q_BLOCK, axis=2)
        s = jnp.einsum('bhqd,bhkd->bhqk', qb, k) * scale
        s = s + Fq[..., :, None] - F[..., None, :]
        q_pos = start + jnp.arange(Q_BLOCK)
        s = jnp.where(k_pos[None, :] <= q_pos[:, None], s, -jnp.inf)
        pr = jax.nn.softmax(s, axis=-1)
        return jnp.einsum('bhqk,bhkd->bhqd', pr, v)

    out = lax.map(block, jnp.arange(T // Q_BLOCK))
    out = out.transpose(1, 0, 3, 2, 4).reshape(B, T, H * Dh)
    return out.astype(f_logit.dtype)


def setup_inputs(seed: int = 0) -> dict:
    key = jax.random.key(seed)
    ks = iter(jax.random.split(key, 32))
    f32 = jnp.float32
    nrm = lambda shape, s: jax.random.normal(next(ks), shape, f32) * s
    gain = lambda shape: 1.0 + 0.02 * jax.random.normal(next(ks), shape, f32)
    uni = lambda shape, lo, hi: jax.random.uniform(next(ks), shape, f32, lo, hi)
    L = DEPTH
    return {
        "x": nrm((BATCH, SEQ, D_MODEL), 1.0),
        "p": nrm((DEPTH, BATCH, SEQ, D_PLE), 1.0),
        "pre_norm_g": gain((L, D_MODEL)),
        "w_in": nrm((L, D_MODEL, IN_COLS), D_MODEL ** -0.5),
        "rw_mu_r": uni((L, RW_WIDTH), 0.0, 1.0),
        "rw_mu_k": uni((L, RW_WIDTH), 0.0, 1.0),
        "rw_mu_v": uni((L, RW_WIDTH), 0.0, 1.0),
        "rw_mu_w": uni((L, DECAY_LORA), 0.0, 1.0),
        "rw_mu_a": uni((L, AAA_LORA), 0.0, 1.0),
        "rw_w0": uni((L, RW_WIDTH), -3.0, 0.5),
        "rw_w2": nrm((L, DECAY_LORA, RW_WIDTH), 0.5 * DECAY_LORA ** -0.5),
        "rw_a0": nrm((L, RW_WIDTH), 0.1),
        "rw_a2": nrm((L, AAA_LORA, RW_WIDTH), AAA_LORA ** -0.5),
        "rw_k_k": 0.85 + nrm((L, RW_WIDTH), 0.02),
        "rw_k_a": gain((L, RW_WIDTH)),
        "rw_r_k": nrm((L, RW_HEADS, RW_HEAD_DIM), 0.1),
        "rw_ln_w": gain((L, RW_WIDTH)),
        "rw_ln_b": nrm((L, RW_WIDTH), 0.01),
        "fx_b_f": uni((L, FX_HEADS), 1.0, 5.0),
        "fx_q_g": gain((L, FX_HEAD_DIM)),
        "fx_k_g": gain((L, FX_HEAD_DIM)),
        "w_out": nrm((L, D_MIX, D_MODEL), D_MIX ** -0.5),
        "post_norm_g": gain((L, D_MODEL)),
        "ple_norm_g": gain((L, D_MODEL)),
        "w_ple_gate": nrm((L, D_MODEL, D_MODEL), D_MODEL ** -0.5),
        "w_ple": nrm((L, D_PLE, D_MODEL), D_PLE ** -0.5),
    }


def reference(x, p, pre_norm_g, w_in, rw_mu_r, rw_mu_k, rw_mu_v, rw_mu_w, rw_mu_a,
              rw_w0, rw_w2, rw_a0, rw_a2, rw_k_k, rw_k_a, rw_r_k, rw_ln_w, rw_ln_b,
              fx_b_f, fx_q_g, fx_k_g, w_out, post_norm_g, ple_norm_g, w_ple_gate, w_ple):
    offs = _split_offsets()
    for i in range(DEPTH):
        h = rms_norm(x, pre_norm_g[i])
        z = h @ w_in[i]
        (rr, rk, rv, rg, rw, ra, fq, fk, fv, fg, ff) = jnp.split(z, offs, axis=-1)
        y_rw = rwkv7_branch(rr, rk, rv, rw, ra, rw_mu_r[i], rw_mu_k[i], rw_mu_v[i],
                            rw_mu_w[i], rw_mu_a[i], rw_w0[i], rw_w2[i], rw_a0[i], rw_a2[i],
                            rw_k_k[i], rw_k_a[i], rw_r_k[i], rw_ln_w[i], rw_ln_b[i])
        y_fx = forgetting_attention(fq, fk, fv, ff, fx_b_f[i], fx_q_g[i], fx_k_g[i])
        y = jnp.concatenate([(y_rw * jax.nn.silu(rg)).astype(h.dtype),
                             (y_fx * jax.nn.silu(fg)).astype(h.dtype)], axis=-1)
        m = y @ w_out[i]
        x = x + rms_norm(m, post_norm_g[i])
        gate = jax.nn.sigmoid(rms_norm(x, ple_norm_g[i]) @ w_ple_gate[i])
        x = x + gate * (p[i] @ w_ple[i])
    return x
```

```cpp
#include <hip/hip_runtime.h>
#include <hip/hip_cooperative_groups.h>
#include <cstdio>
#include <cstdint>
namespace pg8 {
#define PG8_LAS __attribute__((address_space(3)))
typedef unsigned short bf16_t;
typedef short bf16x8 __attribute__((ext_vector_type(8)));
typedef float f32x4 __attribute__((ext_vector_type(4)));
typedef unsigned u32x4 __attribute__((ext_vector_type(4)));
constexpr int BM = 256, BK = 64, HALF = 128, HTB = HALF * BK * 2  , STAGE_BYTES = 8 * HTB, NXCD = 8, WGM = 8;

__host__ __device__ __forceinline__ int lds_byte(int r, int c) { const int st = (r >> 4) * 2 + (c >> 5), rr = r & 15, cc = c & 31, ob = rr * 64 + cc * 2; return st * 1024 + (ob ^ (((ob >> 9) & 1) << 5)); }
__host__ __device__ __forceinline__ void stage_rc(int b, int& R, int& C) { const int st = b / 1024, sb = b % 1024, swz = sb ^ (((sb >> 9) & 1) << 5); R = (st >> 1) * 16 + swz / 64; C = (st & 1) * 32 + (swz % 64) / 2; }
__host__ __device__ __forceinline__ int perm32(int rho) { const int n = rho >> 4, i = rho & 15; return 8 * (i >> 2) + 4 * n + (i & 3); }

struct Unit { int pm, pn; };
struct Gemm { const bf16_t* A; const bf16_t* Bt; int M, N, K; };

struct StaticOrder {
    int nM, nN, nwg, G, c;
    __host__ __device__ void init(int M, int N, int G_, int c_) { nM = M / BM; nN = N / BM; nwg = nM * nN; G = G_; c = c_; }
    __host__ __device__ bool next(int i, Unit& u) const {
        const long L = (long)i * G + c; if (L >= nwg) return false;
        int wgid = (int)L; { const int q = nwg / NXCD, r = nwg % NXCD, xcd = wgid % NXCD, off = wgid / NXCD; wgid = (xcd < r ? xcd * (q + 1) : r * (q + 1) + (xcd - r) * q) + off; }
        const int nig = WGM * nN, gid = wgid / nig, fm = gid * WGM, gsz = (nM - fm) < WGM ? (nM - fm) : WGM;
        u.pm = fm + ((wgid % nig) % gsz); u.pn = (wgid % nig) / gsz; return true;
    }
    __device__ __forceinline__ void a_ready(const Unit&) const {}
    __device__ __forceinline__ void done(const Unit&) const {}
};

__device__ __forceinline__ unsigned cvt_pk_bf16(float lo, float hi) { unsigned r; asm volatile("v_cvt_pk_bf16_f32 %0, %1, %2" : "=v"(r) : "v"(lo), "v"(hi)); return r; }
typedef float f32x2 __attribute__((ext_vector_type(2)));
__device__ __forceinline__ f32x2 gelu_pk(f32x2 v) {
    const f32x2 av = __builtin_elementwise_abs(v), d = av * 0.2316418882f + 1.0f;
    f32x2 t; t.x = __builtin_amdgcn_rcpf(d.x); t.y = __builtin_amdgcn_rcpf(d.y);
    f32x2 q = t * 0.5307027145f + (-0.7265760135f); q = q * t + 0.7107068705f; q = q * t + (-0.142248368f); q = q * t + 0.127414796f; q = q * t;
    const f32x2 s = (v * v) * (-0.72134752044f);
    f32x2 e; e.x = __builtin_amdgcn_exp2f(s.x); e.y = __builtin_amdgcn_exp2f(s.y);
    const f32x2 m = v * (q * e), r = v - m;
    f32x2 o; o.x = v.x < 0.f ? m.x : r.x; o.y = v.y < 0.f ? m.y : r.y; return o;
}

template <int ACT  > struct EpiBf16 {
    static constexpr bool PERM = true, AFTER_DRAIN = false; static_assert(ACT == 0 || ACT == 1, "EpiBf16: ACT is 0 (none) or 1 (gelu_pk)");
    bf16_t* O; int ldc; const float* bias; int split_cols; size_t split_stride; float scale0;
    __device__ __forceinline__ void operator()(const f32x4 (&acc)[2][2][4][2], const Unit& u, int wr, int wc, int fr, int fq) const {
        const int row0 = u.pm * BM + wr * 64 + fr; int colt = u.pn * BM; bf16_t* base = O;
        float sc = 1.f; if (split_cols) { const int t = colt / split_cols; base += (size_t)t * split_stride; colt -= t * split_cols; if (t == 0) sc = scale0; }
        const int col0 = colt + wc * 32 + 8 * fq, bcol0 = u.pn * BM + wc * 32 + 8 * fq;
        f32x4 bv[2][2];
#pragma unroll
        for (int bj = 0; bj < 2; ++bj)
#pragma unroll
            for (int n = 0; n < 2; ++n) bv[bj][n] = bias ? *(const f32x4*)(bias + bcol0 + bj * HALF + 4 * n) : (f32x4){0.f, 0.f, 0.f, 0.f};
#pragma unroll
        for (int ai = 0; ai < 2; ++ai)
#pragma unroll
            for (int m = 0; m < 4; ++m) { bf16_t* rowp = base + (size_t)(row0 + ai * HALF + m * 16) * ldc + col0;
#pragma unroll
                for (int bj = 0; bj < 2; ++bj) { f32x4 v0 = acc[ai][bj][m][0] + bv[bj][0], v1 = acc[ai][bj][m][1] + bv[bj][1];
                    if (ACT == 1) { f32x2 a = gelu_pk((f32x2){v0[0], v0[1]}), b = gelu_pk((f32x2){v0[2], v0[3]}), c = gelu_pk((f32x2){v1[0], v1[1]}), d = gelu_pk((f32x2){v1[2], v1[3]});
                        v0 = (f32x4){a.x, a.y, b.x, b.y}; v1 = (f32x4){c.x, c.y, d.x, d.y}; }
                    v0 = v0 * sc; v1 = v1 * sc; u32x4 w; w.x = cvt_pk_bf16(v0[0], v0[1]); w.y = cvt_pk_bf16(v0[2], v0[3]); w.z = cvt_pk_bf16(v1[0], v1[1]); w.w = cvt_pk_bf16(v1[2], v1[3]);
                    *(u32x4*)(rowp + bj * HALF) = w; } }
    }
};
template <class Epi, class Sched, bool ALIGN_EPI = false, bool SP2 = false>
__device__ __forceinline__ void gemm_phase(PG8_LAS unsigned char* lds, const Gemm g, const Sched& S, const Epi& E, const int wave_) {
    int tid_ = wave_ * 64 + ({ int l__; asm volatile("v_mbcnt_lo_u32_b32 %0, -1, 0\n\tv_mbcnt_hi_u32_b32 %0, -1, %0" : "=v"(l__)); l__; }); asm volatile("" : "+v"(tid_));
    const int tid = tid_, wid = __builtin_amdgcn_readfirstlane(tid >> 6), lane = tid & 63, wr = wid >> 2, wc = wid & 3, fr = lane & 15, fq = lane >> 4;
    const int K = g.K, nt = K / BK;
    unsigned voffA[2], voffB[2];
#pragma unroll
    for (int i = 0; i < 2; ++i) { int R, C; stage_rc(tid * 16 + i * 8192, R, C); const int Rb = Epi::PERM ? ((R & ~31) + perm32(R & 31)) : R;
        voffA[i] = (unsigned)(R * K + C) * 2u; voffB[i] = (unsigned)(Rb * K + C) * 2u; }
    const size_t kstep = (size_t)(BK * 2);
    const size_t hstep = (size_t)HALF * K * 2;
    const size_t tstep = 2 * hstep;
    const unsigned ldsw = (unsigned)wid * 1024u;
    const int aoff = lds_byte(wr * 64 + fr, fq * 8), boff = lds_byte(wc * 32 + fr, fq * 8);
#define PG8_SA(b, h) (((b) * 2 + (h)) * HTB)
#define PG8_SB(b, h) ((4 + (b) * 2 + (h)) * HTB)
#define PG8_STAGE(bufoff, gbase, voff) do { _Pragma("unroll") for (int _i = 0; _i < 2; ++_i) \
        __builtin_amdgcn_global_load_lds((const unsigned*)((const char*)(gbase) + (voff)[_i]), (PG8_LAS unsigned*)(lds + (bufoff) + ldsw + _i * 8192), 16, 0, 0); } while (0)
#define PG8_LDA(dst, b, h) do { _Pragma("unroll") for (int m = 0; m < 4; ++m) _Pragma("unroll") for (int k = 0; k < 2; ++k) dst[m][k] = *(const PG8_LAS bf16x8*)(lds + PG8_SA(b, h) + aoff + m * 2048 + k * 1024); } while (0)
#define PG8_LDB(dst, b, h) do { _Pragma("unroll") for (int n = 0; n < 2; ++n) _Pragma("unroll") for (int k = 0; k < 2; ++k) dst[n][k] = *(const PG8_LAS bf16x8*)(lds + PG8_SB(b, h) + boff + n * 2048 + k * 1024); } while (0)
#define PG8_MMA(ai, bj, At, Bt) do { __builtin_amdgcn_s_setprio(1); _Pragma("unroll") for (int m = 0; m < 4; ++m) _Pragma("unroll") for (int n = 0; n < 2; ++n) _Pragma("unroll") for (int k = 0; k < 2; ++k) \
        acc[ai][bj][m][n] = __builtin_amdgcn_mfma_f32_16x16x32_bf16(Bt[n][k], At[m][k], acc[ai][bj][m][n], 0, 0, 0); __builtin_amdgcn_s_setprio(0); } while (0)
#define PG8_WAIT_V(n) asm volatile("s_waitcnt vmcnt(" #n ")" ::: "memory")
#define PG8_WAIT_L(n) asm volatile("s_waitcnt lgkmcnt(" #n ")" ::: "memory")
#define PG8_BAR __builtin_amdgcn_s_barrier()
#define PG8_SCHED __builtin_amdgcn_sched_barrier(0)
    Unit cur, nxt; int ui = 0;
    if (!S.next(0, cur)) return;
    f32x4 acc[2][2][4][2];
#pragma unroll
    for (int a = 0; a < 2; ++a)
#pragma unroll
        for (int b = 0; b < 2; ++b)
#pragma unroll
            for (int m = 0; m < 4; ++m)
#pragma unroll
                for (int n = 0; n < 2; ++n) acc[a][b][m][n] = (f32x4){0.f, 0.f, 0.f, 0.f};
    bf16x8 At[4][2], B0[2][2], B1[2][2];
    const char* cA = (const char*)g.A + (size_t)cur.pm * tstep; const char* cB = (const char*)g.Bt + (size_t)cur.pn * tstep;
    S.a_ready(cur);
    if constexpr (SP2) {
        PG8_STAGE(PG8_SB(0, 0), cB, voffB); PG8_STAGE(PG8_SB(0, 1), cB + hstep, voffB); PG8_STAGE(PG8_SA(0, 0), cA, voffA); PG8_STAGE(PG8_SA(0, 1), cA + hstep, voffA);
        if (wr == 1) PG8_BAR;
        PG8_WAIT_V(2); PG8_BAR;
        PG8_STAGE(PG8_SB(1, 0), cB + kstep, voffB); PG8_STAGE(PG8_SA(1, 0), cA + kstep, voffA); PG8_STAGE(PG8_SB(1, 1), cB + hstep + kstep, voffB);
        PG8_WAIT_V(6); PG8_BAR;
    } else {
        PG8_STAGE(PG8_SB(0, 0), cB, voffB); PG8_STAGE(PG8_SA(0, 0), cA, voffA); PG8_STAGE(PG8_SB(0, 1), cB + hstep, voffB); PG8_STAGE(PG8_SA(0, 1), cA + hstep, voffA);
        if (wr == 1) PG8_BAR;
        PG8_WAIT_V(4); PG8_BAR;
        PG8_STAGE(PG8_SB(1, 0), cB + kstep, voffB); PG8_STAGE(PG8_SA(1, 0), cA + kstep, voffA); PG8_STAGE(PG8_SB(1, 1), cB + hstep + kstep, voffB);
        PG8_WAIT_V(6); PG8_BAR;
    }
    for (;;) {
        const bool has_next = S.next(ui + 1, nxt);
        const char* nA = has_next ? (const char*)g.A + (size_t)nxt.pm * tstep : cA; const char* nB = has_next ? (const char*)g.Bt + (size_t)nxt.pn * tstep : cB;
        for (int t = 0; t < nt; t += 2) {
            const bool last = (t == nt - 2);
            const char* a1 = cA + (size_t)(t + 1) * kstep;
            const char* a2 = last ? nA : cA + (size_t)(t + 2) * kstep; const char* b2 = last ? nB : cB + (size_t)(t + 2) * kstep;
            const char* a3 = a2 + kstep; const char* b3 = b2 + kstep;
            if (last && has_next) S.a_ready(nxt);
            if constexpr (SP2) {
            PG8_LDB(B0, 0, 0); PG8_LDB(B1, 0, 1); PG8_SCHED; PG8_LDA(At, 0, 0); PG8_STAGE(PG8_SA(1, 1), a1 + hstep, voffA);
            PG8_WAIT_V(8); PG8_WAIT_L(0); PG8_BAR; PG8_MMA(0, 0, At, B0); PG8_MMA(0, 1, At, B1); PG8_BAR; PG8_SCHED;
            PG8_LDA(At, 0, 1); PG8_STAGE(PG8_SB(0, 0), b2, voffB); PG8_STAGE(PG8_SB(0, 1), b2 + hstep, voffB); PG8_STAGE(PG8_SA(0, 0), a2, voffA);
            PG8_WAIT_V(8); PG8_WAIT_L(0); PG8_BAR; PG8_MMA(1, 0, At, B0); PG8_MMA(1, 1, At, B1); PG8_BAR; PG8_SCHED;
            PG8_LDB(B0, 1, 0); PG8_LDB(B1, 1, 1); PG8_SCHED; PG8_LDA(At, 1, 0); PG8_STAGE(PG8_SA(0, 1), a2 + hstep, voffA);
            PG8_WAIT_V(8); PG8_WAIT_L(0); PG8_BAR; PG8_MMA(0, 0, At, B0); PG8_MMA(0, 1, At, B1); PG8_BAR; PG8_SCHED;
            PG8_LDA(At, 1, 1); PG8_STAGE(PG8_SB(1, 0), b3, voffB); PG8_STAGE(PG8_SB(1, 1), b3 + hstep, voffB); PG8_STAGE(PG8_SA(1, 0), a3, voffA);
            PG8_WAIT_V(8); PG8_WAIT_L(0); PG8_BAR; PG8_MMA(1, 0, At, B0); PG8_MMA(1, 1, At, B1); PG8_BAR; PG8_SCHED;
            } else {
            PG8_LDB(B0, 0, 0); PG8_SCHED; PG8_LDA(At, 0, 0); PG8_STAGE(PG8_SA(1, 1), a1 + hstep, voffA);
            PG8_WAIT_L(8); PG8_BAR; PG8_WAIT_L(0); PG8_MMA(0, 0, At, B0); PG8_BAR; PG8_SCHED;
            PG8_LDB(B1, 0, 1); PG8_STAGE(PG8_SB(0, 0), b2, voffB);
            PG8_BAR; PG8_WAIT_L(0); PG8_MMA(0, 1, At, B1); PG8_BAR;
            PG8_LDA(At, 0, 1); PG8_STAGE(PG8_SA(0, 0), a2, voffA);
            PG8_BAR; PG8_WAIT_L(0); PG8_MMA(1, 0, At, B0); PG8_BAR; PG8_SCHED;
            PG8_STAGE(PG8_SB(0, 1), b2 + hstep, voffB);
            PG8_WAIT_V(6); PG8_BAR; PG8_MMA(1, 1, At, B1); PG8_BAR;
            PG8_LDB(B0, 1, 0); PG8_SCHED; PG8_LDA(At, 1, 0); PG8_STAGE(PG8_SA(0, 1), a2 + hstep, voffA);
            PG8_WAIT_L(8); PG8_BAR; PG8_WAIT_L(0); PG8_MMA(0, 0, At, B0); PG8_BAR; PG8_SCHED;
            PG8_LDB(B1, 1, 1); PG8_STAGE(PG8_SB(1, 0), b3, voffB);
            PG8_BAR; PG8_WAIT_L(0); PG8_MMA(0, 1, At, B1); PG8_BAR;
            PG8_LDA(At, 1, 1); PG8_STAGE(PG8_SA(1, 0), a3, voffA);
            PG8_BAR; PG8_WAIT_L(0); PG8_MMA(1, 0, At, B0); PG8_BAR; PG8_SCHED;
            PG8_STAGE(PG8_SB(1, 1), b3 + hstep, voffB);
            PG8_WAIT_V(6); PG8_BAR; PG8_MMA(1, 1, At, B1); PG8_BAR;
            }
        }
        if constexpr (ALIGN_EPI) { if (wr == 0) PG8_BAR; }
        if constexpr (!Epi::AFTER_DRAIN) { E(acc, cur, wr, wc, fr, fq); S.done(cur); }
        if (!has_next) break;
#pragma unroll
        for (int a = 0; a < 2; ++a)
#pragma unroll
            for (int b = 0; b < 2; ++b)
#pragma unroll
                for (int m = 0; m < 4; ++m)
#pragma unroll
                    for (int n = 0; n < 2; ++n) acc[a][b][m][n] = (f32x4){0.f, 0.f, 0.f, 0.f};
        cur = nxt; cA = nA; cB = nB; ++ui;
        if constexpr (ALIGN_EPI) { if (wr == 1) PG8_BAR; }
    }
    PG8_WAIT_V(0);
    if constexpr (!ALIGN_EPI) { if (wr == 0) PG8_BAR; }
    PG8_BAR;
    if constexpr (Epi::AFTER_DRAIN) { E.fused(acc, cur, wr, wc, fr, fq, lds, wid, lane); S.done(cur); }
#undef PG8_SA
#undef PG8_SB
#undef PG8_STAGE
#undef PG8_LDA
#undef PG8_LDB
#undef PG8_MMA
#undef PG8_WAIT_V
#undef PG8_WAIT_L
#undef PG8_BAR
#undef PG8_SCHED
}
}

#ifndef PG8_SP2
#define PG8_SP2 true
#endif
#ifndef PG8_ALIGN
#define PG8_ALIGN true
#endif
namespace pg8 {
struct EpiZ {
    static constexpr bool PERM = true, AFTER_DRAIN = false;
    bf16_t* ZA; bf16_t* ZB; float* ZS;
    __device__ __forceinline__ void operator()(const f32x4 (&acc)[2][2][4][2], const Unit& u, int wr, int wc, int fr, int fq) const {
        const int row0 = u.pm * BM + wr * 64 + fr; const int colt = u.pn * BM; const int cl = wc * 32 + 8 * fq;
        if (colt >= 8192) {
#pragma unroll
            for (int ai = 0; ai < 2; ++ai)
#pragma unroll
                for (int m = 0; m < 4; ++m) { float* rowp = ZS + (size_t)(row0 + ai * HALF + m * 16) * 256 + cl;
#pragma unroll
                    for (int bj = 0; bj < 2; ++bj) { *(f32x4*)(rowp + bj * HALF) = acc[ai][bj][m][0]; *(f32x4*)(rowp + bj * HALF + 4) = acc[ai][bj][m][1]; } }
        } else {
            bf16_t* base; int ldc, c0; if (colt < 3072) { base = ZA; ldc = 3072; c0 = colt; } else { base = ZB; ldc = 5120; c0 = colt - 3072; }
#pragma unroll
            for (int ai = 0; ai < 2; ++ai)
#pragma unroll
                for (int m = 0; m < 4; ++m) { bf16_t* rowp = base + (size_t)(row0 + ai * HALF + m * 16) * ldc + c0 + cl;
#pragma unroll
                    for (int bj = 0; bj < 2; ++bj) { const f32x4 v0 = acc[ai][bj][m][0], v1 = acc[ai][bj][m][1]; u32x4 w; w.x = cvt_pk_bf16(v0[0], v0[1]); w.y = cvt_pk_bf16(v0[2], v0[3]); w.z = cvt_pk_bf16(v1[0], v1[1]); w.w = cvt_pk_bf16(v1[2], v1[3]);
                        *(u32x4*)(rowp + bj * HALF) = w; } }
        }
    }
};
struct EpiM {
    static constexpr bool PERM = true, AFTER_DRAIN = false;
    bf16_t* O; float* SSQ;
    __device__ __forceinline__ void operator()(const f32x4 (&acc)[2][2][4][2], const Unit& u, int wr, int wc, int fr, int fq) const {
        const int row0 = u.pm * BM + wr * 64 + fr; const int col0 = u.pn * BM + wc * 32 + 8 * fq;
#pragma unroll
        for (int ai = 0; ai < 2; ++ai)
#pragma unroll
            for (int m = 0; m < 4; ++m) { const int row = row0 + ai * HALF + m * 16; bf16_t* rowp = O + (size_t)row * 2048 + col0; float s = 0.f;
#pragma unroll
                for (int bj = 0; bj < 2; ++bj) { const f32x4 v0 = acc[ai][bj][m][0], v1 = acc[ai][bj][m][1];
                    s += (v0[0] * v0[0] + v0[1] * v0[1]) + (v0[2] * v0[2] + v0[3] * v0[3]) + (v1[0] * v1[0] + v1[1] * v1[1]) + (v1[2] * v1[2] + v1[3] * v1[3]);
                    u32x4 w; w.x = cvt_pk_bf16(v0[0], v0[1]); w.y = cvt_pk_bf16(v0[2], v0[3]); w.z = cvt_pk_bf16(v1[0], v1[1]); w.w = cvt_pk_bf16(v1[2], v1[3]);
                    *(u32x4*)(rowp + bj * HALF) = w; }
                s += __shfl_xor(s, 16); s += __shfl_xor(s, 32);
                if (fq == 0) SSQ[(size_t)row * 32 + u.pn * 4 + wc] = s; }
    }
};
struct EpiFinal {
    static constexpr bool PERM = true, AFTER_DRAIN = false;
    float* OUT; const bf16_t* PLE;
    __device__ __forceinline__ void operator()(const f32x4 (&acc)[2][2][4][2], const Unit& u, int wr, int wc, int fr, int fq) const {
        const int row0 = u.pm * BM + wr * 64 + fr; const int col0 = u.pn * BM + wc * 32 + 8 * fq;
#pragma unroll
        for (int ai = 0; ai < 2; ++ai)
#pragma unroll
            for (int m = 0; m < 4; ++m) { const size_t off = (size_t)(row0 + ai * HALF + m * 16) * 2048 + col0;
#pragma unroll
                for (int bj = 0; bj < 2; ++bj) { const f32x4 a0 = acc[ai][bj][m][0], a1 = acc[ai][bj][m][1];
                    const f32x4 x0 = *(const f32x4*)(OUT + off + bj * HALF), x1 = *(const f32x4*)(OUT + off + bj * HALF + 4); const u32x4 pl = *(const u32x4*)(PLE + off + bj * HALF);
                    f32x4 o0, o1;
#pragma unroll
                    for (int e = 0; e < 2; ++e) { const float pl0 = __uint_as_float(pl[e] << 16), pl1 = __uint_as_float(pl[e] & 0xffff0000u), ph0 = __uint_as_float(pl[2 + e] << 16), ph1 = __uint_as_float(pl[2 + e] & 0xffff0000u);
                        o0[2 * e] = x0[2 * e] + pl0 * __builtin_amdgcn_rcpf(1.f + __expf(-a0[2 * e])); o0[2 * e + 1] = x0[2 * e + 1] + pl1 * __builtin_amdgcn_rcpf(1.f + __expf(-a0[2 * e + 1]));
                        o1[2 * e] = x1[2 * e] + ph0 * __builtin_amdgcn_rcpf(1.f + __expf(-a1[2 * e])); o1[2 * e + 1] = x1[2 * e + 1] + ph1 * __builtin_amdgcn_rcpf(1.f + __expf(-a1[2 * e + 1])); }
                    *(f32x4*)(OUT + off + bj * HALF) = o0; *(f32x4*)(OUT + off + bj * HALF + 4) = o1; asm volatile("" ::: "memory"); } }
    }
};
}
#include <hip/hip_bf16.h>
#include <cmath>
namespace attn_body {
using bf16=__hip_bfloat16;
using bf16x8=__attribute__((ext_vector_type(8)))short;
using s16x4=__attribute__((ext_vector_type(4)))short;
using f32x16=__attribute__((ext_vector_type(16)))float;
using u32x4=__attribute__((ext_vector_type(4)))unsigned;
using f32x4v=__attribute__((ext_vector_type(4)))float;
constexpr int BATCH=1,NHEAD=16,SEQ=16384,D=64,DM=5120,PO=2048;
constexpr int NW=8,QBLK=32,QB=QBLK*NW,KVBLK=64,NQB=SEQ/QB;
constexpr int ATTN_PITCH=DM, ATTN_UNIT_ROWS=QB;
__device__ __forceinline__ int crow(int r,int hi){return (r&3)+8*(r>>2)+4*hi;}
#define SBAR() __builtin_amdgcn_sched_barrier(0)
__device__ __forceinline__ void cmask(f32x16&p0,f32x16&p1,int jb,int qrel,int hi){
  const float NEG=-INFINITY; int dq=qrel-(64*jb+4*hi); asm volatile("":"+v"(dq));
  #pragma unroll
  for(int r=0;r<16;++r){const int c=(r&3)+8*(r>>2); if(c>dq)p0[r]=NEG; if(c+32>dq)p1[r]=NEG;}
}

constexpr int NSLOT=3, SLOTB=8192;
constexpr int LDS_K=0, LDS_V=NSLOT*SLOTB, LDS_WS=2*NSLOT*SLOTB, LDS_OST=LDS_WS+NW*64*4, LDS_F=LDS_OST+NW*4096,LDS_BYTES=LDS_F+SEQ*4;
constexpr float C2=0.125f*1.4426950408889634f;
__device__ __forceinline__ void glds16(const void*gsrc,unsigned lds_dst){unsigned keep;
  asm volatile("s_mov_b32 %0, m0\n\ts_mov_b32 m0, %2\n\ts_nop 0\n\tglobal_load_lds_dwordx4 %1, off\n\ts_mov_b32 m0, %0":"=&s"(keep):"v"(gsrc),"s"(lds_dst):"memory");}
__device__ __forceinline__ float max3f(float a,float b,float c){float r;asm("v_max3_f32 %0, %1, %2, %3":"=v"(r):"v"(a),"v"(b),"v"(c));return r;}
__device__ __forceinline__ float max2f(float a,float b){float r;asm("v_max_f32_e32 %0, %1, %2":"=v"(r):"v"(a),"v"(b));return r;}
__device__ __forceinline__ float fadd_s(float a,float b){float r;asm("v_add_f32_e32 %0, %1, %2":"=v"(r):"v"(a),"v"(b));return r;}
__device__ __forceinline__ float fsub_s(float a,float b){float r;asm("v_sub_f32_e32 %0, %1, %2":"=v"(r):"v"(a),"v"(b));return r;}
typedef float f32x2_t __attribute__((ext_vector_type(2))); typedef __bf16 bf16x2_t __attribute__((ext_vector_type(2)));
__device__ __forceinline__ unsigned cvtpk_s(float lo,float hi){f32x2_t v={lo,hi};bf16x2_t b=__builtin_convertvector(v,bf16x2_t);return __builtin_bit_cast(unsigned,b);}
#define WAIT_BAR(N) asm volatile("s_waitcnt vmcnt(" #N ") lgkmcnt(0)\n\ts_barrier":::"memory")

__device__ __forceinline__ void qkt(f32x16&p0,f32x16&p1,const char*Kslot,const bf16x8*qr,int r32,int hi){
  const char*kb=Kslot+hi*1024+r32*16;
  #pragma unroll
  for(int d0=0;d0<4;++d0){
    const bf16x8 b0=*reinterpret_cast<const bf16x8*>(kb+d0*2048);
    const bf16x8 b1=*reinterpret_cast<const bf16x8*>(kb+d0*2048+512);
    {p0=__builtin_amdgcn_mfma_f32_32x32x16_bf16(b0,qr[d0],p0,0,0,0);p1=__builtin_amdgcn_mfma_f32_32x32x16_bf16(b1,qr[d0],p1,0,0,0);}}
}
typedef __attribute__((address_space(3))) const char* lds_cptr;
typedef short v4i16_t __attribute__((ext_vector_type(4)));
__device__ __forceinline__ void kload8(bf16x8*kf,lds_cptr kp){
  kf[0]=*(const __attribute__((address_space(3))) bf16x8*)(kp);      kf[1]=*(const __attribute__((address_space(3))) bf16x8*)(kp+512);
  kf[2]=*(const __attribute__((address_space(3))) bf16x8*)(kp+2048); kf[3]=*(const __attribute__((address_space(3))) bf16x8*)(kp+2560);
  kf[4]=*(const __attribute__((address_space(3))) bf16x8*)(kp+4096); kf[5]=*(const __attribute__((address_space(3))) bf16x8*)(kp+4608);
  kf[6]=*(const __attribute__((address_space(3))) bf16x8*)(kp+6144); kf[7]=*(const __attribute__((address_space(3))) bf16x8*)(kp+6656);
}
__device__ __forceinline__ void kload2(bf16x8*kf,lds_cptr kp,int j){ kf[2*j]=*(const __attribute__((address_space(3))) bf16x8*)(kp+j*2048); kf[2*j+1]=*(const __attribute__((address_space(3))) bf16x8*)(kp+j*2048+512); }
__device__ __forceinline__ s16x4 vtr(lds_cptr p){ return __builtin_bit_cast(s16x4,__builtin_amdgcn_ds_read_tr16_b64_v4i16((__attribute__((address_space(3))) v4i16_t*)p)); }
__device__ __forceinline__ float rowmax(const f32x16&p0,const f32x16&p1){
  float a=max3f(p0[0],p0[1],p1[0]),b=max3f(p0[2],p0[3],p1[1]);a=max3f(a,p1[2],p1[3]);
  #pragma unroll
  for(int r=4;r<16;r+=4){a=max3f(a,p0[r],p0[r+1]);b=max3f(b,p0[r+2],p0[r+3]);a=max3f(a,p1[r],p1[r+1]);b=max3f(b,p1[r+2],p1[r+3]);}
  const float m=max2f(a,b);
  auto rr=__builtin_amdgcn_permlane32_swap(__float_as_uint(m),__float_as_uint(m),false,false);
  return max2f(__uint_as_float(rr[0]),__uint_as_float(rr[1]));
}
__device__ __forceinline__ void pv(f32x16*o,int vb,bf16x8 pa0,bf16x8 pa1,bf16x8 pa2,bf16x8 pa3){
  #pragma unroll
  for(int d0=0;d0<2;++d0){s16x4 lo[4],hi[4];
    #pragma unroll
    for(int ks=0;ks<4;++ks){
      asm volatile("ds_read_b64_tr_b16 %0,%1 offset:%c2":"=&v"(lo[ks]):"v"(vb),"i"(d0*4096+ks*1024):"memory");
      asm volatile("ds_read_b64_tr_b16 %0,%1 offset:%c2":"=&v"(hi[ks]):"v"(vb),"i"(d0*4096+ks*1024+512):"memory");}
    asm volatile("s_waitcnt lgkmcnt(0)":::"memory");SBAR();
    #define PK(k) (bf16x8){lo[k][0],lo[k][1],lo[k][2],lo[k][3],hi[k][0],hi[k][1],hi[k][2],hi[k][3]}
    o[d0]=__builtin_amdgcn_mfma_f32_32x32x16_bf16(pa0,PK(0),o[d0],0,0,0);
    o[d0]=__builtin_amdgcn_mfma_f32_32x32x16_bf16(pa1,PK(1),o[d0],0,0,0);
    o[d0]=__builtin_amdgcn_mfma_f32_32x32x16_bf16(pa2,PK(2),o[d0],0,0,0);
    o[d0]=__builtin_amdgcn_mfma_f32_32x32x16_bf16(pa3,PK(3),o[d0],0,0,0);
    #undef PK
  }
}

#ifndef ATTN_STORE16
#define ATTN_STORE16(p,v) (*(u32x4*)(p)=(v))
#endif
template<int THRL> __device__ __forceinline__ void attn_unit(int h,int qb,const bf16*Q,const bf16*__restrict__ K,const bf16*__restrict__ V,const bf16*__restrict__ G,bf16*O,const float*__restrict__ F2h,char*shm,const int wave_,const int ts){
  const int wid=wave_; int lane_=({ int l__; asm volatile("v_mbcnt_lo_u32_b32 %0, -1, 0\n\tv_mbcnt_hi_u32_b32 %0, -1, %0" : "=v"(l__)); l__; }); asm volatile("":"+v"(lane_)); const int lane=lane_,tid=wid*64+lane,r32=lane&31,hi=lane>>5;
  const long rowbase=0; const int q0=qb*QB;
  const bf16*Qw=Q+(rowbase+q0+wid*QBLK)*DM+h*D;
  const bf16*Kh=K+(long)ts*KVBLK*DM+h*D,*Vh=V+(long)ts*KVBLK*DM+h*D;
  const unsigned lds0=(unsigned)(uintptr_t)shm;
  float*wsf=(float*)(shm+LDS_WS)+wid*64;
  const bf16*ksrc=Kh+(long)lane*DM+wid*8;
  const bf16*vsrc=Vh+(long)(16*(wid&3)+(lane>>2))*DM+(wid>>2)*32+(lane&3)*8;
  const unsigned kdst=lds0+LDS_K+wid*1024, vdst=lds0+LDS_V+wid*1024;
  #define DMA_K(t,slot) glds16(ksrc+(long)(t)*KVBLK*DM,(unsigned)__builtin_amdgcn_readfirstlane(kdst+(slot)))
  #define DMA_V(t,slot) glds16(vsrc+(long)(t)*KVBLK*DM,(unsigned)__builtin_amdgcn_readfirstlane(vdst+(slot)))
  const int vb0=(int)(lds0+LDS_V)+((lane>>4)&1)*32+(lane&3)*8+(4*hi+((lane&15)>>2))*64;
  const char*Kbase=shm+LDS_K; bf16x8 kf[8];
  const lds_cptr shm3=(lds_cptr)shm; const lds_cptr kp0=shm3+LDS_K+hi*1024+r32*16; const lds_cptr vp0=shm3+LDS_V+((lane>>4)&1)*32+(lane&3)*8+(4*hi+((lane&15)>>2))*64;
  const int NT=(q0+QB)/KVBLK-ts;
  { typedef __attribute__((address_space(3))) f32x4v* lf4; const f32x4v*src=(const f32x4v*)(F2h+ts*KVBLK); lf4 dst=(lf4)((__attribute__((address_space(3))) char*)shm3+LDS_F); for(int i=tid;i<NT*16;i+=NW*64)dst[i]=src[i]; }
  const float fq2=F2h[q0+wid*QBLK+r32];
  asm volatile("s_waitcnt vmcnt(0) lgkmcnt(0)":::"memory");
  DMA_K(0,0);DMA_V(0,0);DMA_K(1,SLOTB);
  bf16x8 qr[4];
  #pragma unroll
  for(int d0=0;d0<4;++d0)qr[d0]=*reinterpret_cast<const bf16x8*>(&Qw[(long)r32*DM+d0*16+hi*8]);
  float fref=fq2  ,l_reg=0.f;f32x16 o[2];o[0]=f32x16{};o[1]=f32x16{};
  const int qrel=wid*QBLK+r32;
  typedef __attribute__((address_space(3))) const f32x4v* lds_f4c; const lds_f4c fbase=(lds_f4c)(shm3+LDS_F+16*hi);
  #define FLOAD(P0,P1,t) do{ const lds_f4c fp_=fbase+(t)*16; _Pragma("unroll") for(int j_=0;j_<4;++j_){ const f32x4v a_=fp_[2*j_], b_=fp_[8+2*j_]; \
      P0[4*j_]=a_[0];P0[4*j_+1]=a_[1];P0[4*j_+2]=a_[2];P0[4*j_+3]=a_[3]; P1[4*j_]=b_[0];P1[4*j_+1]=b_[1];P1[4*j_+2]=b_[2];P1[4*j_+3]=b_[3]; } }while(0)
  #define FSUB(P0,P1) do{ const float base_=fref; _Pragma("unroll") for(int r=0;r<16;++r){P0[r]=base_-P0[r];P1[r]=base_-P1[r];} }while(0)
  #define CMASK(P0,P1,t) do{int jb_=(t)-(NT-4); if(jb_>=0)cmask(P0,P1,jb_,qrel,hi);}while(0)
  bool resc=false;
  #define START(P0,P1) do{ const float rm=rowmax(P0,P1); resc=false; \
    { const float dl=rm; fref=fsub_s(fref,dl); \
      _Pragma("unroll") for(int r=0;r<16;++r){P0[r]=fsub_s(P0[r],dl);P1[r]=fsub_s(P1[r],dl);} \
      } \
    _Pragma("unroll") for(int r=0;r<16;++r)P0[r]=__builtin_amdgcn_exp2f(P0[r]); }while(0)
  #define RESC() do{ if(resc){ asm volatile("s_waitcnt lgkmcnt(0)":::"memory"); \
      _Pragma("unroll") for(int d_=0;d_<2;++d_) _Pragma("unroll") for(int r=0;r<16;++r)o[d_][r]*=wsf[crow(r,hi)]; } }while(0)
  f32x16 pA0,pA1,pB0,pB1;
  int sl_prev=0,sl_cur=0,sl_next=SLOTB;
  #define ROT() do{sl_prev=sl_cur;sl_cur=sl_next;sl_next=(sl_next==(NSLOT-1)*SLOTB)?0:sl_next+SLOTB;}while(0)
  DMA_K(2,2*SLOTB);
  WAIT_BAR(3);
  FLOAD(pA0,pA1,0); FSUB(pA0,pA1); qkt(pA0,pA1,Kbase,qr,r32,hi);asm volatile("s_nop 15\n\ts_nop 7":"+v"(pA0),"+v"(pA1));CMASK(pA0,pA1,0);
  START(pA0,pA1);
  _Pragma("unroll") for(int r=0;r<16;++r)pA1[r]=__builtin_amdgcn_exp2f(pA1[r]);
  WAIT_BAR(0);
  DMA_K(3,0);DMA_V(1,SLOTB);
  ROT();
  kload8(kf,kp0+sl_cur); FLOAD(pB0,pB1,1);
  WAIT_BAR(2);
  s16x4 vlo[8],vhi[8]; u32x4 pw0,pw1,pw2,pw3;
  #define PKW(P,B) cvtpk_s(P[B],P[B+1])
  #define PAF(k) __builtin_bit_cast(bf16x8,pw##k)
  #define VFR(i) (bf16x8){vlo[i][0],vlo[i][1],vlo[i][2],vlo[i][3],vhi[i][0],vhi[i][1],vhi[i][2],vhi[i][3]}
  #define PIN(x) asm volatile("":"+v"(x))
  #define MX3(a,b,c) __builtin_fmaxf(__builtin_fmaxf((a),(b)),(c))
  #define GAPA(MF,A0,A1,A2,A3,W0,W1,PW) do{ MF; sacc+=A0; sacc+=A1; sacc+=A2; sacc+=A3; PIN(sacc); W0; W1; PIN(PW); SBAR(); }while(0)
  #define EX(v) __builtin_amdgcn_exp2f(v)
  #define GAPB(MF,X,B) do{ MF; X[B]=EX(X[B]); X[B+1]=EX(X[B+1]); X[B+2]=EX(X[B+2]); X[B+3]=EX(X[B+3]); PIN(X); SBAR(); }while(0)
  #define VRD(i) do{ vlo[i]=vtr(vp_+(((i)>>2)*4096+((i)&3)*1024)); vhi[i]=vtr(vp_+(((i)>>2)*4096+((i)&3)*1024+512)); }while(0)
  #define KRD(G,j) do{ if(G){ kload2(kf,kp0+sl_next,j); SBAR(); } }while(0)
  #define STEP(C0,C1,P0,P1,t,GK,GV,GL) do{ SBAR(); FSUB(C0,C1); SBAR(); \
    const lds_cptr vp_=vp0+sl_prev; \
    VRD(0); SBAR(); float sacc=(P0[0]+P0[1]); \
    GAPA(C0=__builtin_amdgcn_mfma_f32_32x32x16_bf16(kf[0],qr[0],C0,0,0,0), P0[2],P0[3],P0[4],P0[5],     pw0[0]=PKW(P0,0), pw0[1]=PKW(P0,2), pw0); \
    VRD(4); SBAR(); GAPA(C1=__builtin_amdgcn_mfma_f32_32x32x16_bf16(kf[1],qr[0],C1,0,0,0), P0[6],P0[7],P0[8],P0[9],     pw0[2]=PKW(P0,4), pw0[3]=PKW(P0,6), pw0); \
    VRD(1); SBAR(); GAPA(C0=__builtin_amdgcn_mfma_f32_32x32x16_bf16(kf[2],qr[1],C0,0,0,0),   P0[10],P0[11],P0[12],P0[13], pw1[0]=PKW(P0,8), pw1[1]=PKW(P0,10), pw1); \
    VRD(5); SBAR(); GAPA(C1=__builtin_amdgcn_mfma_f32_32x32x16_bf16(kf[3],qr[1],C1,0,0,0),   P0[14],P0[15],P1[0],P1[1],   pw1[2]=PKW(P0,12),pw1[3]=PKW(P0,14), pw1); \
    VRD(2); SBAR(); GAPA(C0=__builtin_amdgcn_mfma_f32_32x32x16_bf16(kf[4],qr[2],C0,0,0,0),   P1[2],P1[3],P1[4],P1[5],     pw2[0]=PKW(P1,0), pw2[1]=PKW(P1,2), pw2); \
    VRD(6); SBAR(); GAPA(C1=__builtin_amdgcn_mfma_f32_32x32x16_bf16(kf[5],qr[2],C1,0,0,0),   P1[6],P1[7],P1[8],P1[9],     pw2[2]=PKW(P1,4), pw2[3]=PKW(P1,6), pw2); \
    VRD(3); SBAR(); GAPA(C0=__builtin_amdgcn_mfma_f32_32x32x16_bf16(kf[6],qr[3],C0,0,0,0),   P1[10],P1[11],P1[12],P1[13], pw3[0]=PKW(P1,8), pw3[1]=PKW(P1,10), pw3); \
    VRD(7); SBAR(); GAPA(C1=__builtin_amdgcn_mfma_f32_32x32x16_bf16(kf[7],qr[3],C1,0,0,0),   P1[14],P1[15],0.f,0.f,       pw3[2]=PKW(P1,12),pw3[3]=PKW(P1,14), pw3); \
    l_reg+=sacc; \
    if(GK){DMA_K((t)+3,sl_cur);} if(GV){DMA_V((t)+1,sl_next);} \
    CMASK(C0,C1,t); \
    { float a=MX3(C0[0],C0[1],C1[0]),b=MX3(C0[2],C0[3],C1[1]); a=MX3(a,C1[2],C1[3]); \
      _Pragma("unroll") for(int r=4;r<16;r+=4){a=MX3(a,C0[r],C0[r+1]);b=MX3(b,C0[r+2],C0[r+3]);a=MX3(a,C1[r],C1[r+1]);b=MX3(b,C1[r+2],C1[r+3]);} \
      float rm=__builtin_fmaxf(a,b); { auto rr=__builtin_amdgcn_permlane32_swap(__float_as_uint(rm),__float_as_uint(rm),false,false); rm=__builtin_fmaxf(__uint_as_float(rr[0]),__uint_as_float(rr[1])); } \
      resc=false; \
      if(__builtin_expect(__any(rm>(float)THRL),0)){ const float dl=__builtin_fmaxf(rm,0.f); fref-=dl; \
        _Pragma("unroll") for(int r=0;r<16;++r){C0[r]-=dl;C1[r]-=dl;} \
        const float f=__builtin_amdgcn_exp2f(-dl); l_reg*=f; { int l2_; asm volatile("v_mbcnt_lo_u32_b32 %0, -1, 0\n\tv_mbcnt_hi_u32_b32 %0, -1, %0":"=v"(l2_)); if(l2_<32)wsf[l2_]=f; } resc=true; } } \
    SBAR(); \
    GAPB(o[0]=__builtin_amdgcn_mfma_f32_32x32x16_bf16(PAF(0),VFR(0),o[0],0,0,0), C0,0); \
    GAPB(o[1]=__builtin_amdgcn_mfma_f32_32x32x16_bf16(PAF(0),VFR(4),o[1],0,0,0), C0,4); \
    KRD(GL,0); GAPB(o[0]=__builtin_amdgcn_mfma_f32_32x32x16_bf16(PAF(1),VFR(1),o[0],0,0,0), C0,8); \
    KRD(GL,1); GAPB(o[1]=__builtin_amdgcn_mfma_f32_32x32x16_bf16(PAF(1),VFR(5),o[1],0,0,0), C0,12); \
    KRD(GL,2); GAPB(o[0]=__builtin_amdgcn_mfma_f32_32x32x16_bf16(PAF(2),VFR(2),o[0],0,0,0), C1,0); \
    KRD(GL,3); GAPB(o[1]=__builtin_amdgcn_mfma_f32_32x32x16_bf16(PAF(2),VFR(6),o[1],0,0,0), C1,4); \
    GAPB(o[0]=__builtin_amdgcn_mfma_f32_32x32x16_bf16(PAF(3),VFR(3),o[0],0,0,0), C1,8); \
    GAPB(o[1]=__builtin_amdgcn_mfma_f32_32x32x16_bf16(PAF(3),VFR(7),o[1],0,0,0), C1,12); \
    if(GL){ FLOAD(P0,P1,(t)+1); } \
    }while(0)
  int t=1;
  #undef CMASK
  #define CMASK(P0,P1,t) do{}while(0)
  for(;t+5<NT;t+=2){
    STEP(pB0,pB1,pA0,pA1,t,true,true,true);     WAIT_BAR(2); RESC(); ROT();
    STEP(pA0,pA1,pB0,pB1,t+1,true,true,true);   WAIT_BAR(2); RESC(); ROT();
  }
  #undef CMASK
  #define CMASK(P0,P1,t) do{int jb_=(t)-(NT-4); if(jb_>=0)cmask(P0,P1,jb_,qrel,hi);}while(0)
  #define ENDW(tt) do{ if((tt)+3<NT){WAIT_BAR(2);} else if((tt)+2<NT){WAIT_BAR(1);} else {WAIT_BAR(0);} }while(0)
  for(;t+1<NT;t+=2){
    STEP(pB0,pB1,pA0,pA1,t,(t+3<NT),(t+1<NT),(t+1<NT));       ENDW(t);   RESC(); ROT();
    STEP(pA0,pA1,pB0,pB1,t+1,(t+4<NT),(t+2<NT),(t+2<NT));     ENDW(t+1); RESC(); ROT();
  }
  STEP(pB0,pB1,pA0,pA1,NT-1,false,false,false); RESC();
  { float sacc=pB0[0]+pB0[1]; _Pragma("unroll") for(int r=2;r<16;++r)sacc+=pB0[r]; _Pragma("unroll") for(int r=0;r<16;++r)sacc+=pB1[r]; l_reg+=sacc;
    pw0=(u32x4){PKW(pB0,0),PKW(pB0,2),PKW(pB0,4),PKW(pB0,6)};pw1=(u32x4){PKW(pB0,8),PKW(pB0,10),PKW(pB0,12),PKW(pB0,14)};pw2=(u32x4){PKW(pB1,0),PKW(pB1,2),PKW(pB1,4),PKW(pB1,6)};pw3=(u32x4){PKW(pB1,8),PKW(pB1,10),PKW(pB1,12),PKW(pB1,14)};
    SBAR(); pv(o,vb0+sl_cur,PAF(0),PAF(1),PAF(2),PAF(3)); }
  #undef PKW
  #undef PAF
  #undef VFR
  #undef PIN
  #undef MX3
  #undef GAPA
  #undef GAPB
  #undef EX
  #undef VRD
  #undef KRD
  #undef STEP
  #undef ENDW
  {auto rr=__builtin_amdgcn_permlane32_swap(__float_as_uint(l_reg),__float_as_uint(l_reg),false,false);l_reg=__uint_as_float(rr[0])+__uint_as_float(rr[1]);}
  if(hi==0)wsf[32+r32]=l_reg;asm volatile("s_waitcnt lgkmcnt(0)":::"memory");
  float rli[16];
  #pragma unroll
  for(int r=0;r<16;++r)rli[r]=__builtin_amdgcn_rcpf(wsf[32+crow(r,hi)]);
  bf16*Ow=O+(long)(q0+wid*QBLK)*PO+h*D; const bf16*Gw=G+(long)(q0+wid*QBLK)*DM+h*D;
  { bf16*stg=(bf16*)(shm+LDS_OST)+wid*2048;
    #pragma unroll
    for(int r=0;r<16;++r){const int orow=crow(r,hi);
      #pragma unroll
      for(int d0=0;d0<2;++d0)stg[orow*64+d0*32+r32]=__float2bfloat16(o[d0][r]*rli[r]);}
    asm volatile("s_waitcnt lgkmcnt(0)":::"memory");
    #pragma unroll
    for(int i=0;i<4;++i){const int row=i*8+(lane>>3),ch=lane&7; u32x4 v=*(const u32x4*)(stg+row*64+ch*8); const u32x4 g=*(const u32x4*)(Gw+(long)row*DM+ch*8);
      _Pragma("unroll") for(int e=0;e<4;++e){ const float gl=__uint_as_float(g[e]<<16), gh=__uint_as_float(g[e]&0xffff0000u), vl=__uint_as_float(v[e]<<16), vh=__uint_as_float(v[e]&0xffff0000u);
        const float sl=gl*__builtin_amdgcn_rcpf(1.f+__expf(-gl)), sh=gh*__builtin_amdgcn_rcpf(1.f+__expf(-gh)); v[e]=cvtpk_s(vl*sl,vh*sh); }
      ATTN_STORE16(Ow+(long)row*PO+ch*8,v);} }
  asm volatile("s_waitcnt lgkmcnt(0)\n\ts_barrier":::"memory");
  #undef DMA_K
  #undef DMA_V
  #undef CMASK
  #undef START
  #undef RESC
  #undef ROT
  #undef FLOAD
  #undef FSUB
}
constexpr int ATTN_LDS_BYTES=LDS_BYTES;
#undef SBAR
#undef WAIT_BAR
}
namespace cg = cooperative_groups;
constexpr int NWAVES = 8, NTHR = 512;
constexpr int T = 16384, DMODEL = 2048, INCOLS = 8336, NPAD = 8448, DPLE = 256, RW = 1024, FX = 1024, NH = 16, HD = 64;
constexpr int M = T;
constexpr float RMS_EPS = 1e-6f, GN_EPS = 64e-5f, LOG2E = 1.4426950408889634f;
constexpr size_t MiB = 1u << 20;
constexpr size_t WS_CTL = 0, WS_WIN = 1 * MiB, WS_WOUT = 34 * MiB, WS_WGATE = 42 * MiB, WS_WPLE = 50 * MiB, WS_W2T = 51 * MiB, WS_A2T = 51 * MiB + 512 * 1024, WS_PB = 52 * MiB,
                 WS_F2 = 60 * MiB, WS_RK = 61 * MiB, WS_SSQ = 62 * MiB, WS_XN = 64 * MiB, WS_ZS = 128 * MiB, WS_ZA = 144 * MiB, WS_ZB = 240 * MiB, WS_KP = 400 * MiB, WS_RS = 432 * MiB, WS_VS = 464 * MiB, WS_END = 500 * MiB;
constexpr size_t WS_YR = WS_ZA, WS_MB = WS_ZB, WS_PLE = WS_ZB + 64 * MiB;
constexpr size_t OUT_W1A = 0, OUT_QA = 32 * MiB, OUT_BT = 64 * MiB, OUT_KT = 96 * MiB;
constexpr size_t WS_U0 = WS_KP, WS_Y0 = WS_RS, WS_DD = 496 * MiB;
constexpr int LDS_BYTES = 154624;
constexpr int MISC_OFF = 153600;
constexpr int NRWB = 64;
#define LAS __attribute__((address_space(3)))
typedef unsigned short bf16;
typedef unsigned v4u __attribute__((ext_vector_type(4)));
typedef unsigned v2u __attribute__((ext_vector_type(2)));
typedef float f32x4 __attribute__((ext_vector_type(4)));
typedef short bf16x8 __attribute__((ext_vector_type(8)));
#define LDS_WAIT() asm volatile("s_waitcnt lgkmcnt(0)" ::: "memory")
#define RLX_AGENT __ATOMIC_RELAXED, __HIP_MEMORY_SCOPE_AGENT
#define LDS_WAIT() asm volatile("s_waitcnt lgkmcnt(0)" ::: "memory")
#define XB_TMO      128
#define XB_XCNT(j)  (256  + 64 * (j))
#define XB_XSUB(j)  (1280 + 64 * (j))
#define XB_XGEN(j)  (2304 + 64 * (j))
#define XB_TOP      3328
#define XB_TOPGEN   3392
#define XCD_BAR_WORDS 3456
#define XB_SPIN_CAP (1u << 22)

__device__ __forceinline__ unsigned xb_ld(unsigned* p)              { return __hip_atomic_load(p, __ATOMIC_RELAXED, __HIP_MEMORY_SCOPE_AGENT); }
__device__ __forceinline__ unsigned xb_add(unsigned* p, unsigned v) { return __hip_atomic_fetch_add(p, v, __ATOMIC_RELAXED, __HIP_MEMORY_SCOPE_AGENT); }
__device__ __forceinline__ unsigned xb_xcc_id() { return (unsigned)__builtin_amdgcn_s_getreg((3 << 11) | 20) & 0xFu; }
#define XB_SPIN(cond, bar) do { unsigned _sp = 0; while (cond) { __builtin_amdgcn_s_sleep(1); \
    if ((++_sp & 255u) == 0u) { if (xb_ld(&(bar)[XB_TMO])) break; if (_sp > XB_SPIN_CAP) { atomicAdd(&(bar)[XB_TMO], 1u); break; } } } } while (0)

struct XcdBarrier {
    unsigned* bar; unsigned x;
    volatile LAS unsigned* st;
};

__device__ __forceinline__ XcdBarrier xcd_barrier_post(unsigned* bar, volatile LAS unsigned* st, int tid) {
    XcdBarrier b; b.bar = bar; b.x = xb_xcc_id(); b.st = st;
    if (tid == 0) (void)xb_add(&bar[XB_XCNT(b.x)], 1u);
    return b;
}
__device__ __forceinline__ void xcd_barrier_complete(unsigned* bar, unsigned x, unsigned& nloc, unsigned& nx) {
    const unsigned G = gridDim.x * gridDim.y * gridDim.z;
    unsigned sum, cnt, mine, sp = 0u;
    for (;;) {
        sum = 0u; cnt = 0u; mine = 0u;
#pragma unroll
        for (unsigned j = 0; j < 16; ++j) { const unsigned c = xb_ld(&bar[XB_XCNT(j)]); sum += c; cnt += (c > 0u) ? 1u : 0u; mine = (j == x) ? c : mine; }
        if (sum == G) break;
        __builtin_amdgcn_s_sleep(1);
        if ((++sp & 255u) == 0u) { if (xb_ld(&bar[XB_TMO])) break; if (sp > XB_SPIN_CAP) { atomicAdd(&bar[XB_TMO], 1u); break; } }
    }
    nloc = mine > 0u ? mine : 1u; nx = cnt > 0u ? cnt : 1u;
}

__device__ __forceinline__ void xcd_barrier(const XcdBarrier& b, int tid) {
    asm volatile("s_waitcnt vmcnt(0)" ::: "memory");
    __syncthreads();
    if (tid == 0) {
        unsigned* bar = b.bar;
        __builtin_amdgcn_s_waitcnt(0);
        unsigned nloc = b.st[0], nx = b.st[1];
        if (nloc == 0u) { xcd_barrier_complete(bar, b.x, nloc, nx); b.st[0] = nloc; b.st[1] = nx; }
        const unsigned old = xb_add(&bar[XB_XSUB(b.x)], 1u);
        const unsigned gen = old / nloc;
        if (old + 1u == (gen + 1u) * nloc) {
            __builtin_amdgcn_fence(__ATOMIC_RELEASE, "agent");
            asm volatile("s_waitcnt vmcnt(0)" ::: "memory");
            const unsigned og = xb_add(&bar[XB_TOP], 1u);
            const unsigned tg = og / nx;
            if (og + 1u == (tg + 1u) * nx) xb_add(&bar[XB_TOPGEN], 1u);
            else XB_SPIN(xb_ld(&bar[XB_TOPGEN]) == tg, bar);
            __builtin_amdgcn_fence(__ATOMIC_ACQUIRE, "agent");
            xb_add(&bar[XB_XGEN(b.x)], 1u);
            asm volatile("s_waitcnt vmcnt(0)" ::: "memory");
        } else {
            XB_SPIN(xb_ld(&bar[XB_XGEN(b.x)]) == gen, bar);
            __builtin_amdgcn_fence(__ATOMIC_ACQUIRE, "agent");
            asm volatile("s_waitcnt vmcnt(0)" ::: "memory");
        }
    }
    __syncthreads();
}
__device__ __forceinline__ unsigned f2bf(float f) { unsigned u = __builtin_bit_cast(unsigned, f); return (u + 0x7fffu + ((u >> 16) & 1u)) >> 16; }
typedef float f32x2_ __attribute__((ext_vector_type(2))); typedef __bf16 bf16x2_ __attribute__((ext_vector_type(2)));
__device__ __forceinline__ unsigned pk2(float lo, float hi) { f32x2_ v = {lo, hi}; return __builtin_bit_cast(unsigned, __builtin_convertvector(v, bf16x2_)); }
__device__ __forceinline__ float bflo(unsigned u) { return __uint_as_float(u << 16); }
__device__ __forceinline__ float bfhi(unsigned u) { return __uint_as_float(u & 0xffff0000u); }
__device__ __forceinline__ float wave_sum(float v) {
#pragma unroll
    for (int o = 1; o < 64; o <<= 1) v += __shfl_xor(v, o);
    return v;
}
__device__ __forceinline__ float dpp_add(float x, float y_src, int) { return x + y_src; }
__device__ __forceinline__ float row16_sum(float x) {
    x += __uint_as_float(__builtin_amdgcn_update_dpp(0, __float_as_uint(x), 0xB1, 0xf, 0xf, false));
    x += __uint_as_float(__builtin_amdgcn_update_dpp(0, __float_as_uint(x), 0x4E, 0xf, 0xf, false));
    x += __uint_as_float(__builtin_amdgcn_update_dpp(0, __float_as_uint(x), 0x141, 0xf, 0xf, false));
    x += __uint_as_float(__builtin_amdgcn_update_dpp(0, __float_as_uint(x), 0x140, 0xf, 0xf, false));
    return x;
}
__device__ __forceinline__ float quad_sum(float x) {
    x += __uint_as_float(__builtin_amdgcn_update_dpp(0, __float_as_uint(x), 0xB1, 0xf, 0xf, false));
    x += __uint_as_float(__builtin_amdgcn_update_dpp(0, __float_as_uint(x), 0x4E, 0xf, 0xf, false));
    return x;
}
struct Args { const float* in[26]; float* out; unsigned char* ws; };
__device__ __forceinline__ int lane_id() { int l__; asm volatile("v_mbcnt_lo_u32_b32 %0, -1, 0\n\tv_mbcnt_hi_u32_b32 %0, -1, %0" : "=v"(l__)); return l__; }
struct Frame {
    LAS unsigned char* lds; int wave, G, gw, NGW, lane, tid;
};
#define PHASE_BEGIN() do { int l_ = lane_id(); asm volatile("" : "+v"(l_)); F.lane = l_; F.tid = F.wave * 64 + l_; } while (0)

__device__ __forceinline__ void p0_transpose_item(const float* W, int K, int N, bf16* WT, int k0, int n0, int dst_row0, LAS float* scr, int lane) {
    const bool ok = (n0 + (lane & 31)) < N;
    float tv[32];
#pragma unroll
    for (int i = 0; i < 32; ++i) { const int kk = 2 * i + (lane >> 5); tv[i] = ok ? W[(size_t)(k0 + kk) * N + n0 + (lane & 31)] : 0.f; }
#pragma unroll
    for (int i = 0; i < 32; ++i) { const int kk = 2 * i + (lane >> 5); scr[kk * 33 + (lane & 31)] = tv[i]; }
    LDS_WAIT(); asm volatile("" ::: "memory");
    const int c = lane & 7;
#pragma unroll
    for (int j = 0; j < 4; ++j) { const int n = (lane >> 3) + 8 * j; const LAS float* s = scr + (8 * c) * 33 + n;
        v4u o; o.x = pk2(s[0 * 33], s[1 * 33]); o.y = pk2(s[2 * 33], s[3 * 33]); o.z = pk2(s[4 * 33], s[5 * 33]); o.w = pk2(s[6 * 33], s[7 * 33]);
        *(v4u*)(WT + (size_t)(dst_row0 + n) * K + k0 + 8 * c) = o; }
    LDS_WAIT(); asm volatile("" ::: "memory");
}
__device__ __forceinline__ int win_map(int c) {
    if (c < 3072) return c;
    if (c < 4096) return c - 3072 + 7168;
    if (c < 4160) return c - 4096 + 8192;
    if (c < 4224) return c - 4160 + 8256;
    if (c < 8320) return c - 4224 + 3072;
    return c - 8320 + 8320;
}
__device__ __forceinline__ void rms_row_to_bf16(const float* xrow, const float* g, bf16* orow, int lane) {
    const f32x4* xr = (const f32x4*)xrow + lane; const f32x4* gr = (const f32x4*)g + lane;
    f32x4 v[8]; float s = 0.f;
#pragma unroll
    for (int j = 0; j < 8; ++j) { v[j] = xr[64 * j]; s += (v[j].x * v[j].x + v[j].y * v[j].y) + (v[j].z * v[j].z + v[j].w * v[j].w); }
    const float rstd = 1.f / sqrtf(wave_sum(s) * (1.f / DMODEL) + RMS_EPS);
    v2u* o8 = (v2u*)orow + lane;
#pragma unroll
    for (int j = 0; j < 8; ++j) { const f32x4 gg = gr[64 * j]; v2u o; o.x = pk2(v[j].x * rstd * gg.x, v[j].y * rstd * gg.y); o.y = pk2(v[j].z * rstd * gg.z, v[j].w * rstd * gg.w); o8[64 * j] = o; }
}

__device__ __forceinline__ void rms_row2_to_bf16(const float* x0, const float* x1, const float* g, bf16* o0, bf16* o1, int lane) {
    const f32x4* xr0 = (const f32x4*)x0 + lane; const f32x4* xr1 = (const f32x4*)x1 + lane; const f32x4* gr = (const f32x4*)g + lane;
    f32x4 v[8], w[8]; float s = 0.f, t = 0.f;
#pragma unroll
    for (int j = 0; j < 8; ++j) { v[j] = xr0[64 * j]; w[j] = xr1[64 * j]; }
#pragma unroll
    for (int j = 0; j < 8; ++j) { s += (v[j].x * v[j].x + v[j].y * v[j].y) + (v[j].z * v[j].z + v[j].w * v[j].w); t += (w[j].x * w[j].x + w[j].y * w[j].y) + (w[j].z * w[j].z + w[j].w * w[j].w); }
#pragma unroll
    for (int o = 1; o < 64; o <<= 1) { s += __shfl_xor(s, o); t += __shfl_xor(t, o); }
    const float r0 = 1.f / sqrtf(s * (1.f / DMODEL) + RMS_EPS), r1 = 1.f / sqrtf(t * (1.f / DMODEL) + RMS_EPS);
    v2u* p0 = (v2u*)o0 + lane; v2u* p1 = (v2u*)o1 + lane;
#pragma unroll
    for (int j = 0; j < 8; ++j) { const f32x4 gg = gr[64 * j]; const f32x4 a0 = v[j] * r0 * gg, a1 = w[j] * r1 * gg; v2u q0, q1; q0.x = pk2(a0.x, a0.y); q0.y = pk2(a0.z, a0.w); q1.x = pk2(a1.x, a1.y); q1.y = pk2(a1.z, a1.w); p0[64 * j] = q0; p1[64 * j] = q1; }
}
__device__ __forceinline__ void p0_prologue(Frame& F, const Args& a) {
    unsigned char* ws = a.ws;
    LAS float* scr = (LAS float*)(F.lds + F.wave * 16384);
    bf16* Wt_in = (bf16*)(ws + WS_WIN); bf16* Wt_out = (bf16*)(ws + WS_WOUT); bf16* Wt_gate = (bf16*)(ws + WS_WGATE); bf16* Wt_ple = (bf16*)(ws + WS_WPLE); bf16* W2t = (bf16*)(ws + WS_W2T); bf16* A2t = (bf16*)(ws + WS_A2T);
    constexpr int NB_IN = (INCOLS + 31) / 32;
    constexpr int I_IN = (DMODEL / 64) * NB_IN, I_SQ = (DMODEL / 64) * (DMODEL / 32), I_PLE = (DPLE / 64) * (DMODEL / 32), I_LORA = (64 / 64) * (RW / 32);
    constexpr int NITEMS = I_IN + 2 * I_SQ + I_PLE + 2 * I_LORA;
    for (int it = F.gw; it < NITEMS; it += F.NGW) {
        int r = it;
        if (r < I_IN) { const int kb = r / NB_IN, nb = r % NB_IN; p0_transpose_item(a.in[3], DMODEL, INCOLS, Wt_in, 64 * kb, 32 * nb, win_map(32 * nb), scr, F.lane); continue; } r -= I_IN;
        if (r < I_SQ) { const int kb = r / 64, nb = r % 64; p0_transpose_item(a.in[21], DMODEL, DMODEL, Wt_out, 64 * kb, 32 * nb, 32 * nb, scr, F.lane); continue; } r -= I_SQ;
        if (r < I_SQ) { const int kb = r / 64, nb = r % 64; p0_transpose_item(a.in[24], DMODEL, DMODEL, Wt_gate, 64 * kb, 32 * nb, 32 * nb, scr, F.lane); continue; } r -= I_SQ;
        if (r < I_PLE) { const int kb = r / 64, nb = r % 64; p0_transpose_item(a.in[25], DPLE, DMODEL, Wt_ple, 64 * kb, 32 * nb, 32 * nb, scr, F.lane); continue; } r -= I_PLE;
        if (r < I_LORA) { p0_transpose_item(a.in[10], 64, RW, W2t, 0, 32 * r, 32 * r, scr, F.lane); continue; } r -= I_LORA;
        p0_transpose_item(a.in[12], 64, RW, A2t, 0, 32 * r, 32 * r, scr, F.lane);
    }
    { v4u* z = (v4u*)(Wt_in + (size_t)8352 * DMODEL); const int n16 = (NPAD - 8352) * DMODEL * 2 / 16; const v4u zero = {0u, 0u, 0u, 0u};
      for (int i = F.gw * 64 + F.lane; i < n16; i += F.NGW * 64) z[i] = zero; }
    bf16* XN = (bf16*)(ws + WS_XN);
    for (int m = F.gw; m < M; m += 2 * F.NGW) rms_row2_to_bf16(a.in[0] + (size_t)m * DMODEL, a.in[0] + (size_t)(m + F.NGW) * DMODEL, a.in[2], XN + (size_t)m * DMODEL, XN + (size_t)(m + F.NGW) * DMODEL, F.lane);
    { const f32x4* p4 = (const f32x4*)a.in[1]; v4u* o = (v4u*)(ws + WS_PB); const int n8 = M * DPLE / 8;
      for (int i = F.gw * 64 + F.lane; i < n8; i += F.NGW * 64) { const f32x4 u0 = p4[2 * i], u1 = p4[2 * i + 1]; v4u w; w.x = pk2(u0.x, u0.y); w.y = pk2(u0.z, u0.w); w.z = pk2(u1.x, u1.y); w.w = pk2(u1.z, u1.w); o[i] = w; } }
}

__device__ __forceinline__ float log_sigmoid(float x) { return fminf(x, 0.f) - log1pf(expf(-fabsf(x))); }
__device__ __forceinline__ void p2a_fgroup(Frame& F, const Args& a, int g) {
    const float* ZS = (const float*)(a.ws + WS_ZS); float* F2 = (float*)(a.ws + WS_F2); float* PS = (float*)(a.ws + WS_SSQ);
    LAS float* sc = (LAS float*)F.lds;
    const int h = F.tid & 15, r0 = F.tid >> 4; const float bf = a.in[18][h];
#pragma unroll
    for (int k = 0; k < 2; ++k) { const int r = r0 + 32 * k; sc[r * 16 + h] = log_sigmoid(ZS[(size_t)(g * 64 + r) * 256 + 128 + h] + bf) * LOG2E; }
    __syncthreads();
    if (F.tid < 16) { float run = 0.f; for (int r = 0; r < 64; ++r) { run += sc[r * 16 + F.tid]; sc[r * 16 + F.tid] = run; } PS[g * 16 + F.tid] = run; }
    __syncthreads();
#pragma unroll
    for (int k = 0; k < 2; ++k) { const int r = r0 + 32 * k; F2[(size_t)h * T + g * 64 + r] = sc[r * 16 + h]; }
    __syncthreads();
}
__device__ __forceinline__ void p2b_fgroup(Frame& F, const Args& a, int g) {
    float* F2 = (float*)(a.ws + WS_F2); const float* PS = (const float*)(a.ws + WS_SSQ);
    LAS float* sc = (LAS float*)F.lds;
    const int h = F.tid & 15, part = F.tid >> 4; float s = 0.f;
    for (int gg = part; gg < g; gg += 32) s += PS[gg * 16 + h];
    sc[part * 16 + h] = s; __syncthreads();
    if (F.tid < 16) { float o = 0.f; for (int p = 0; p < 32; ++p) o += sc[p * 16 + F.tid]; sc[512 + F.tid] = o; }
    __syncthreads();
    const float off = sc[512 + h];
#pragma unroll
    for (int k = 0; k < 2; ++k) { const int r = part + 32 * k; F2[(size_t)h * T + g * 64 + r] += off; }
    __syncthreads();
}
__device__ __forceinline__ void p2_qknorm_row(const Args& a, int row, int lane) {
    bf16* zb = (bf16*)(a.ws + WS_ZB) + (size_t)row * 5120;
#pragma unroll
    for (int part = 0; part < 2; ++part) {
        v4u* p = (v4u*)(zb + part * 1024 + lane * 16); const v4u u0 = p[0], u1 = p[1];
        float x[16];
#pragma unroll
        for (int e = 0; e < 4; ++e) { x[2 * e] = bflo(u0[e]); x[2 * e + 1] = bfhi(u0[e]); x[8 + 2 * e] = bflo(u1[e]); x[8 + 2 * e + 1] = bfhi(u1[e]); }
        float ss = 0.f;
#pragma unroll
        for (int e = 0; e < 16; ++e) ss += x[e] * x[e];
        ss = quad_sum(ss);
        const float rstd = (1.f / sqrtf(ss * (1.f / 64.f) + RMS_EPS)) * (part == 0 ? attn_body::C2 : 1.f);
        const f32x4* g4 = (const f32x4*)(a.in[part == 0 ? 19 : 20] + (lane & 3) * 16);
        v4u o0, o1;
#pragma unroll
        for (int e = 0; e < 2; ++e) { const f32x4 ga = g4[e], gb = g4[2 + e];
            o0[2 * e] = pk2(x[4 * e] * rstd * ga.x, x[4 * e + 1] * rstd * ga.y); o0[2 * e + 1] = pk2(x[4 * e + 2] * rstd * ga.z, x[4 * e + 3] * rstd * ga.w);
            o1[2 * e] = pk2(x[8 + 4 * e] * rstd * gb.x, x[8 + 4 * e + 1] * rstd * gb.y); o1[2 * e + 1] = pk2(x[8 + 4 * e + 2] * rstd * gb.z, x[8 + 4 * e + 3] * rstd * gb.w); }
        p[0] = o0; p[1] = o1;
    }
}
__device__ __forceinline__ f32x4 ld4(const float* p) { return *(const f32x4*)p; }
__device__ __forceinline__ f32x4 bf4(v2u u) { return (f32x4){bflo(u.x), bfhi(u.x), bflo(u.y), bfhi(u.y)}; }
__device__ __forceinline__ v2u pk4(f32x4 v) { v2u o; o.x = pk2(v.x, v.y); o.y = pk2(v.z, v.w); return o; }
__device__ __forceinline__ float fast_tanh(float x) { x = fminf(fmaxf(x, -15.f), 15.f); const float e = __expf(2.f * x); return (e - 1.f) / (e + 1.f); }
typedef short bf16x4s __attribute__((ext_vector_type(4)));
__device__ __forceinline__ bf16x4s pk4s(f32x4 v) { return __builtin_bit_cast(bf16x4s, pk4(v)); }
__device__ __forceinline__ bf16x8 pk8s(f32x4 a, f32x4 b) { v4u u; u.x = pk2(a.x, a.y); u.y = pk2(a.z, a.w); u.z = pk2(b.x, b.y); u.w = pk2(b.z, b.w); return __builtin_bit_cast(bf16x8, u); }
#define MFMA16(a, b, c) __builtin_amdgcn_mfma_f32_16x16x16bf16_1k(a, b, c, 0, 0, 0)
#define MFMA32(a, b, c) __builtin_amdgcn_mfma_f32_16x16x32_bf16(a, b, c, 0, 0, 0)
__device__ __forceinline__ f32x4 exp4(f32x4 x) { return (f32x4){__expf(x.x), __expf(x.y), __expf(x.z), __expf(x.w)}; }
__device__ __forceinline__ f32x4 shfl4(f32x4 v, int src) { return (f32x4){__shfl(v.x, src), __shfl(v.y, src), __shfl(v.z, src), __shfl(v.w, src)}; }
__device__ __forceinline__ void rw_chunk_prep(const Args& a, int head, int tc0, const LAS bf16* TDr, const LAS bf16* DAr, LAS unsigned char* lw_, int lane) {
    unsigned char* ws = a.ws;
    const bf16* ZA = (const bf16*)(ws + WS_ZA);
    const int j = lane & 15, rg = lane >> 4, kg = rg, cbase = head * 64 + 4 * j;
    const bf16* W2t = (const bf16*)(ws + WS_W2T); const bf16* A2t = (const bf16*)(ws + WS_A2T);
    f32x4 accw[4], acca[4];
    {   bf16x8 atd[2], ada[2];
#pragma unroll
        for (int kk = 0; kk < 2; ++kk) { atd[kk] = *(const LAS bf16x8*)(TDr + j * 64 + kk * 32 + kg * 8); ada[kk] = *(const LAS bf16x8*)(DAr + j * 64 + kk * 32 + kg * 8); }
#pragma unroll
        for (int cb = 0; cb < 4; ++cb) { accw[cb] = (f32x4){0.f, 0.f, 0.f, 0.f}; acca[cb] = (f32x4){0.f, 0.f, 0.f, 0.f};
#pragma unroll
            for (int kk = 0; kk < 2; ++kk) { const bf16x8 bw = *(const bf16x8*)(W2t + (size_t)(cbase + cb) * 64 + kk * 32 + kg * 8), ba = *(const bf16x8*)(A2t + (size_t)(cbase + cb) * 64 + kk * 32 + kg * 8);
                accw[cb] = MFMA32(atd[kk], bw, accw[cb]); acca[cb] = MFMA32(ada[kk], ba, acca[cb]); } }
    }
    const f32x4 w0 = ld4(a.in[9] + cbase), a0 = ld4(a.in[11] + cbase), kkw = ld4(a.in[13] + cbase), kaw = ld4(a.in[14] + cbase), rkw = ld4(a.in[15] + cbase);
    const f32x4 mur = ld4(a.in[4] + cbase), muk = ld4(a.in[5] + cbase), muv = ld4(a.in[6] + cbase);
    float* RK = (float*)(ws + WS_RK);
    f32x4 rr[4], km[4], av[4], bv[4], lw[4], vv[4];
    {   const int tt0 = tc0 + 4 * rg; const f32x4 zero = {0.f, 0.f, 0.f, 0.f};
        f32x4 pr = tt0 > 0 ? bf4(*(const v2u*)(ZA + (size_t)(tt0 - 1) * 3072 + cbase)) : zero;
        f32x4 pk = tt0 > 0 ? bf4(*(const v2u*)(ZA + (size_t)(tt0 - 1) * 3072 + 1024 + cbase)) : zero;
        f32x4 pv = tt0 > 0 ? bf4(*(const v2u*)(ZA + (size_t)(tt0 - 1) * 3072 + 2048 + cbase)) : zero;
#pragma unroll
        for (int i = 0; i < 4; ++i) {
            const int tt = tt0 + i;
            const f32x4 zr = bf4(*(const v2u*)(ZA + (size_t)tt * 3072 + cbase)), zk = bf4(*(const v2u*)(ZA + (size_t)tt * 3072 + 1024 + cbase)), zv = bf4(*(const v2u*)(ZA + (size_t)tt * 3072 + 2048 + cbase));
            const f32x4 r = zr + (pr - zr) * mur, k = zk + (pk - zk) * muk, v = zv + (pv - zv) * muv;
            pr = zr; pk = zk; pv = zv;
            f32x4 lwv, alr;
#pragma unroll
            for (int cb = 0; cb < 4; ++cb) { const float x = -(w0[cb] + accw[cb][i]); const float sp = fmaxf(x, 0.f) + __logf(1.f + __expf(-fabsf(x))); lwv[cb] = -__expf(-sp - 0.5f); alr[cb] = __builtin_amdgcn_rcpf(1.f + __expf(-(a0[cb] + acca[cb][i]))); }
            const f32x4 kkr = k * kkw, kmod = k * (1.f + (alr - 1.f) * kaw);
            float ssq = (kkr.x * kkr.x + kkr.y * kkr.y) + (kkr.z * kkr.z + kkr.w * kkr.w);
            const f32x4 rkk = r * kmod * rkw; float rkp = (rkk.x + rkk.y) + (rkk.z + rkk.w);
            ssq = row16_sum(ssq); rkp = row16_sum(rkp);
            const float inv = __builtin_amdgcn_rsqf(fmaxf(ssq, 1e-24f));
            const f32x4 kk = kkr * inv;
            rr[i] = r; km[i] = kmod; av[i] = -kk; bv[i] = kk * alr; lw[i] = lwv; vv[i] = v;
            if (j == 0) RK[(size_t)tt * 16 + head] = rkp;
        }
    }
    f32x4 lci[4], ltot;
    {   lci[0] = lw[0]; lci[1] = lci[0] + lw[1]; lci[2] = lci[1] + lw[2]; lci[3] = lci[2] + lw[3];
        f32x4 s = lci[3];
        const f32x4 t1 = shfl4(s, lane - 16); if (rg >= 1) s = s + t1;
        const f32x4 t2 = shfl4(s, lane - 32); if (rg >= 2) s = s + t2;
        const f32x4 excl = s - lci[3];
        ltot = shfl4(s, 48 + j);
#pragma unroll
        for (int i = 0; i < 4; ++i) lci[i] = lci[i] + excl;
    }
    LAS bf16* TA = (LAS bf16*)lw_; LAS bf16* TR = TA + 1024; LAS bf16* TB = TR + 1024; LAS bf16* TK = TB + 1024; LAS float* MA = (LAS float*)(lw_ + 8192); LAS float* MT = MA + 256;
    f32x4 atT[4], rtT[4], bhT[4], khT[4], vT[4];
    {   f32x4 at[4], rt[4], bh[4], kh[4];
#pragma unroll
        for (int i = 0; i < 4; ++i) { const f32x4 ei = exp4(lci[i]), eo = exp4(-lci[i]), ee = exp4(lci[i] - lw[i]), eh = exp4(ltot - lci[i]);
            at[i] = av[i] * ee; rt[i] = rr[i] * ei; bh[i] = bv[i] * eh; kh[i] = km[i] * eh;
            const int row = 4 * rg + i;
            *(LAS v2u*)(TA + row * 64 + 4 * j) = pk4(at[i]); *(LAS v2u*)(TR + row * 64 + 4 * j) = pk4(rt[i]); *(LAS v2u*)(TB + row * 64 + 4 * j) = pk4(bv[i] * eo); *(LAS v2u*)(TK + row * 64 + 4 * j) = pk4(km[i] * eo); }
#pragma unroll
        for (int cb = 0; cb < 4; ++cb) { atT[cb] = (f32x4){at[0][cb], at[1][cb], at[2][cb], at[3][cb]}; rtT[cb] = (f32x4){rt[0][cb], rt[1][cb], rt[2][cb], rt[3][cb]};
            bhT[cb] = (f32x4){bh[0][cb], bh[1][cb], bh[2][cb], bh[3][cb]}; khT[cb] = (f32x4){kh[0][cb], kh[1][cb], kh[2][cb], kh[3][cb]}; vT[cb] = (f32x4){vv[0][cb], vv[1][cb], vv[2][cb], vv[3][cb]}; }
    }
    LDS_WAIT(); asm volatile("" ::: "memory");
    f32x4 AabT = {0.f, 0.f, 0.f, 0.f}, AakT = AabT, ArbT = AabT, ArkT = AabT;
#pragma unroll
    for (int kk = 0; kk < 2; ++kk) { const int o = j * 64 + kk * 32 + kg * 8;
        const bf16x8 pa = *(const LAS bf16x8*)(TA + o), pr = *(const LAS bf16x8*)(TR + o), pb = *(const LAS bf16x8*)(TB + o), pk = *(const LAS bf16x8*)(TK + o);
        AabT = MFMA32(pb, pa, AabT); AakT = MFMA32(pk, pa, AakT); ArbT = MFMA32(pb, pr, ArbT); ArkT = MFMA32(pk, pr, ArkT); }
#pragma unroll
    for (int e = 0; e < 4; ++e) { const int jp = 4 * rg + e; if (!(jp < j)) { AabT[e] = 0.f; AakT[e] = 0.f; } if (!(jp <= j)) { ArbT[e] = 0.f; ArkT[e] = 0.f; } }
    *(LAS f32x4*)(MA + j * 16 + 4 * rg) = AabT;
    LDS_WAIT(); asm volatile("" ::: "memory");
    {   float x[16];
#pragma unroll
        for (int t = 0; t < 16; ++t) { float s = (t == j) ? 1.f : 0.f;
#pragma unroll
            for (int q = 0; q < 4; ++q) { if (4 * q < t) { const f32x4 row = *(const LAS f32x4*)(MA + t * 16 + 4 * q);
#pragma unroll
                for (int e = 0; e < 4; ++e) if (4 * q + e < t) s += row[e] * x[4 * q + e]; } }
            x[t] = s; }
        if (rg == 0) {
#pragma unroll
            for (int t = 0; t < 16; ++t) MT[t * 16 + j] = x[t]; }
    }
    LDS_WAIT(); asm volatile("" ::: "memory");
    const bf16x4s TmA = pk4s(*(const LAS f32x4*)(MT + j * 16 + 4 * kg));
    const f32x4 z4 = {0.f, 0.f, 0.f, 0.f};
    const bf16x4s aak = pk4s(AakT), arb = pk4s(ArbT), ark = pk4s(ArkT);
    bf16x4s idb; { v2u u; u.x = ((4 * kg + 0 == j) ? 0x3F80u : 0u) | ((4 * kg + 1 == j) ? 0x3F800000u : 0u); u.y = ((4 * kg + 2 == j) ? 0x3F80u : 0u) | ((4 * kg + 3 == j) ? 0x3F800000u : 0u); idb = __builtin_bit_cast(bf16x4s, u); }
    const size_t ch = (size_t)(tc0 >> 4) * 16 + head;
    unsigned char* outb = (unsigned char*)a.out;
    f32x4 W1T[4], QT[4];
#pragma unroll
    for (int cb = 0; cb < 4; ++cb) {
        const bf16x4s atp = pk4s(atT[cb]), vtp = pk4s(vT[cb]);
        const f32x4 W1 = MFMA16(TmA, atp, z4);
        W1T[cb] = MFMA16(atp, TmA, z4);
        const f32x4 X = MFMA16(aak, vtp, z4);
        const f32x4 U0 = MFMA16(TmA, pk4s(X), z4);
        f32x4 q = MFMA16(pk4s(rtT[cb]), idb, z4);
        QT[cb] = MFMA16(pk4s(W1), arb, q);
        f32x4 y0 = MFMA16(arb, pk4s(U0), z4); y0 = MFMA16(ark, vtp, y0);
        *(v2u*)(ws + WS_U0 + ch * 2048 + cb * 512 + lane * 8) = pk4(U0);
        *(v2u*)(ws + WS_Y0 + ch * 2048 + cb * 512 + lane * 8) = pk4(y0);
        *(v2u*)(outb + OUT_BT + ch * 2048 + cb * 512 + lane * 8) = pk4(bhT[cb]);
        *(v2u*)(outb + OUT_KT + ch * 2048 + cb * 512 + lane * 8) = pk4(khT[cb]);
        *(v2u*)(ws + WS_VS + ch * 2048 + cb * 512 + lane * 8) = pk4(vT[cb]);
    }
#pragma unroll
    for (int kk = 0; kk < 2; ++kk) { *(bf16x8*)(outb + OUT_W1A + ch * 2048 + kk * 1024 + lane * 16) = pk8s(W1T[2 * kk], W1T[2 * kk + 1]); *(bf16x8*)(outb + OUT_QA + ch * 2048 + kk * 1024 + lane * 16) = pk8s(QT[2 * kk], QT[2 * kk + 1]); }
    if (rg == 0) { float* dd = (float*)(ws + WS_DD) + ch * 64; const f32x4 dv = exp4(ltot);
#pragma unroll
        for (int cb = 0; cb < 4; ++cb) dd[((j >> 2) * 4 + cb) * 4 + (j & 3)] = dv[cb]; }
    LDS_WAIT(); asm volatile("" ::: "memory");
}
__device__ __forceinline__ void p2_rwprep_tile(Frame& F, const Args& a, int t0) {
    unsigned char* ws = a.ws;
    const float* ZS = (const float*)(ws + WS_ZS);
    LAS bf16* TD = (LAS bf16*)F.lds; LAS bf16* DA = TD + 32 * 64;
    {
        const int tok = F.tid >> 4, c4 = (F.tid & 15) * 4, t = t0 + tok;
        const f32x4 zero = {0.f, 0.f, 0.f, 0.f};
        const f32x4 cw = ld4(ZS + (size_t)t * 256 + c4), ca = ld4(ZS + (size_t)t * 256 + 64 + c4);
        const f32x4 pw = t > 0 ? ld4(ZS + (size_t)(t - 1) * 256 + c4) : zero, pa = t > 0 ? ld4(ZS + (size_t)(t - 1) * 256 + 64 + c4) : zero;
        const f32x4 mw = ld4(a.in[7] + c4), ma = ld4(a.in[8] + c4);
        f32x4 dw = cw + (pw - cw) * mw, da = ca + (pa - ca) * ma;
        dw.x = fast_tanh(dw.x); dw.y = fast_tanh(dw.y); dw.z = fast_tanh(dw.z); dw.w = fast_tanh(dw.w);
        *(LAS v2u*)(TD + tok * 64 + c4) = pk4(dw); *(LAS v2u*)(DA + tok * 64 + c4) = pk4(da);
    }
    __syncthreads();
    LAS unsigned char* lw_ = F.lds + 8192 + F.wave * 10240;
    for (int q = 0; q < 4; ++q) { const int hh = q >> 1, rb = q & 1; rw_chunk_prep(a, 2 * F.wave + hh, t0 + rb * 16, TD + rb * 16 * 64, DA + rb * 16 * 64, lw_, F.lane); }
    __syncthreads();
}

struct ChunkOps { bf16x8 w1[2], qa[2]; bf16x4s bt[4], kt[4]; v2u u0, y0, vb; f32x4 d[4]; };
constexpr int SP_R = 15, SP_D = 14, SP_SLOT = 10240;
__device__ __forceinline__ void rw_slot_read(ChunkOps& C, const LAS unsigned char* s, int ib, int lane) {
    const int rg = lane >> 4;
#pragma unroll
    for (int kk = 0; kk < 2; ++kk) { C.w1[kk] = *(const LAS bf16x8*)(s + kk * 1024 + lane * 16); C.qa[kk] = *(const LAS bf16x8*)(s + 2048 + kk * 1024 + lane * 16); }
#pragma unroll
    for (int t = 0; t < 4; ++t) { C.bt[t] = *(const LAS bf16x4s*)(s + 4096 + t * 512 + lane * 8); C.kt[t] = *(const LAS bf16x4s*)(s + 6144 + t * 512 + lane * 8); C.d[t] = *(const LAS f32x4*)(s + 9728 + (rg * 4 + t) * 16); }
    C.u0 = *(const LAS v2u*)(s + 8192 + lane * 8); C.y0 = *(const LAS v2u*)(s + 8704 + lane * 8);
    C.vb = *(const LAS v2u*)(s + 9216 + lane * 8);
}
struct DmaPtrs { const unsigned char* p[4]; unsigned off[4]; };
__device__ __forceinline__ void rw_dma_init(const Args& a, DmaPtrs& P, int head, int ib, int lw, int lane) {
    const unsigned char* outb = (const unsigned char*)a.out; const unsigned char* ws = a.ws; const size_t c0 = (size_t)head * 2048;
    if (lw == 0) { P.p[0] = outb + OUT_W1A + c0 + lane * 16; P.p[1] = P.p[0] + 1024; P.p[2] = outb + OUT_QA + c0 + lane * 16; P.p[3] = P.p[2] + 1024; P.off[0] = 0u; P.off[1] = 1024u; P.off[2] = 2048u; P.off[3] = 3072u; }
    else if (lw == 1) { P.p[0] = outb + OUT_BT + c0 + lane * 16; P.p[1] = P.p[0] + 1024; P.p[2] = outb + OUT_KT + c0 + lane * 16; P.p[3] = P.p[2] + 1024; P.off[0] = 4096u; P.off[1] = 5120u; P.off[2] = 6144u; P.off[3] = 7168u; }
    else { const int l32 = lane & 31; P.p[0] = ws + WS_U0 + c0 + ib * 512 + l32 * 16; P.p[1] = ws + WS_Y0 + c0 + ib * 512 + l32 * 16; P.p[2] = ws + WS_VS + c0 + ib * 512 + l32 * 16; P.p[3] = ws + WS_DD + (size_t)head * 256 + (lane & 15) * 16;
           P.off[0] = 8192u; P.off[1] = 8704u; P.off[2] = 9216u; P.off[3] = 9728u; }
}
__device__ __forceinline__ void rw_dma_issue(DmaPtrs& P, int lw, int lane, unsigned slot_lds) {
    if (lw < 2) {
#pragma unroll
        for (int q = 0; q < 4; ++q) attn_body::glds16(P.p[q], (unsigned)__builtin_amdgcn_readfirstlane(slot_lds + P.off[q]));
    } else {
        if (lane < 32) {
#pragma unroll
            for (int q = 0; q < 3; ++q) attn_body::glds16(P.p[q], (unsigned)__builtin_amdgcn_readfirstlane(slot_lds + P.off[q])); }
        if (lane < 16) attn_body::glds16(P.p[3], (unsigned)__builtin_amdgcn_readfirstlane(slot_lds + P.off[3]));
    }
#pragma unroll
    for (int q = 0; q < 4; ++q) P.p[q] += (lw == 2 && q == 3) ? 16 * 256 : 16 * 2048;
}
__device__ __forceinline__ void p3_rwkv_state(Frame& F, const Args& a) {
    constexpr int NC = T / 16;
    const int xcd_ = blockIdx.x & 7, sl_ = blockIdx.x >> 3, head = 2 * xcd_ + (sl_ >> 2), ib = sl_ & 3, lane = F.lane, rg = lane >> 4;
    const unsigned lds0 = (unsigned)(uintptr_t)F.lds;
    const bool loader = F.wave >= 1 && F.wave <= 3; const int lw = F.wave - 1;
#define SP_BAR() asm volatile("s_waitcnt lgkmcnt(0)\n\ts_barrier" ::: "memory")
#define SP_WAIT() asm volatile("s_waitcnt vmcnt(48)" ::: "memory")
    if (loader) {
        DmaPtrs P; rw_dma_init(a, P, head, ib, lw, lane);
        for (int n = 0; n < SP_D; ++n) rw_dma_issue(P, lw, lane, lds0 + (unsigned)(n % SP_R) * SP_SLOT);
        SP_WAIT();
        SP_BAR();
        for (int n = 0; n < NC; ++n) {
            if (n + SP_D < NC) { rw_dma_issue(P, lw, lane, lds0 + (unsigned)((n + SP_D) % SP_R) * SP_SLOT); SP_WAIT(); }
            else asm volatile("s_waitcnt vmcnt(0)" ::: "memory");
            SP_BAR();
        }
    } else if (F.wave == 0) {
        float* YR = (float*)(a.ws + WS_YR) + head * 64 + 4 * (lane & 15) + ib;
        f32x4 H[4]; bf16x8 Hb[2];
#pragma unroll
        for (int t = 0; t < 4; ++t) H[t] = (f32x4){0.f, 0.f, 0.f, 0.f};
        Hb[0] = pk8s(H[0], H[1]); Hb[1] = pk8s(H[2], H[3]);
        ChunkOps C, N;
        SP_BAR();
        rw_slot_read(C, F.lds, ib, lane);
#define SP_STEP(CC, NN, n_) do { { const int nn = ((n_) + 1 < NC) ? (n_) + 1 : (n_); rw_slot_read(NN, F.lds + (nn % SP_R) * SP_SLOT, ib, lane); } \
            const bf16x4s Vb = __builtin_bit_cast(bf16x4s, CC.vb); \
            f32x4 U = MFMA32(CC.w1[0], Hb[0], bf4(CC.u0)); U = MFMA32(CC.w1[1], Hb[1], U); \
            f32x4 hk[4]; _Pragma("unroll") for (int t = 0; t < 4; ++t) hk[t] = MFMA16(CC.kt[t], Vb, H[t] * CC.d[t]); \
            f32x4 Y = MFMA32(CC.qa[0], Hb[0], bf4(CC.y0)); Y = MFMA32(CC.qa[1], Hb[1], Y); \
            const bf16x4s Ub = pk4s(U); \
            _Pragma("unroll") for (int t = 0; t < 4; ++t) H[t] = MFMA16(CC.bt[t], Ub, hk[t]); \
            Hb[0] = pk8s(H[0], H[1]); Hb[1] = pk8s(H[2], H[3]); \
            _Pragma("unroll") for (int e = 0; e < 4; ++e) YR[(size_t)(16 * (n_) + 4 * rg + e) * 1024] = Y[e]; \
            asm volatile("s_barrier" ::: "memory");   } while (0)
        for (int n = 0; n < NC; n += 2) { SP_STEP(C, N, n); SP_STEP(N, C, n + 1); }
#undef SP_STEP
    } else {
        for (int n = 0; n < NC + 1; ++n) SP_BAR();
    }
#undef SP_BAR
#undef SP_WAIT
    asm volatile("s_waitcnt vmcnt(0)" ::: "memory"); __syncthreads();
}

__device__ __forceinline__ void p3_gn_chunk(const Args& a, int ch, int lane) {
    const int n = lane & 15, rg = lane >> 4, head = ch & 15, c0 = head * 64 + 4 * n; const int t0 = (ch >> 4) * 16 + 4 * rg;
    const float* YR = (const float*)(a.ws + WS_YR); const bf16* ZB = (const bf16*)(a.ws + WS_ZB); bf16* Y = (bf16*)(a.ws + WS_XN); const float* RK = (const float*)(a.ws + WS_RK);
    const f32x4 lw = ld4(a.in[16] + c0), lb = ld4(a.in[17] + c0);
    f32x4 vimg[4];
#pragma unroll
    for (int cb = 0; cb < 4; ++cb) vimg[cb] = bf4(*(const v2u*)(a.ws + WS_VS + (size_t)ch * 2048 + cb * 512 + lane * 8));
#pragma unroll
    for (int e = 0; e < 4; ++e) { const int t = t0 + e;
        f32x4 y = *(const f32x4*)(YR + (size_t)t * 1024 + c0);
        const f32x4 g = bf4(*(const v2u*)(ZB + (size_t)t * 5120 + 4096 + c0)); const float rk = RK[(size_t)t * 16 + head];
        const float mean = row16_sum((y.x + y.y) + (y.z + y.w)) * (1.f / 64.f);
        y = y - mean;
        const float rstd = __builtin_amdgcn_rsqf(row16_sum((y.x * y.x + y.y * y.y) + (y.z * y.z + y.w * y.w)) * (1.f / 64.f) + GN_EPS);
        const f32x4 v = {vimg[0][e], vimg[1][e], vimg[2][e], vimg[3][e]};
        f32x4 o = y * rstd * lw + lb + v * rk;
#pragma unroll
        for (int k = 0; k < 4; ++k) o[k] *= g[k] * __builtin_amdgcn_rcpf(1.f + __expf(-g[k]));
        *(v2u*)(Y + (size_t)t * 2048 + c0) = pk4(o); }
}
__device__ __forceinline__ void p5_row2(const Args& a, int rowA, int rowB, int lane) {
    const float* SSQ = (const float*)(a.ws + WS_SSQ);
    float sa = lane < 32 ? SSQ[(size_t)rowA * 32 + lane] : 0.f, sb = lane < 32 ? SSQ[(size_t)rowB * 32 + lane] : 0.f;
    const v2u* mbA = (const v2u*)((const bf16*)(a.ws + WS_MB) + (size_t)rowA * 2048) + lane; const v2u* mbB = (const v2u*)((const bf16*)(a.ws + WS_MB) + (size_t)rowB * 2048) + lane;
    const f32x4* xA = (const f32x4*)(a.in[0] + (size_t)rowA * 2048) + lane; const f32x4* xB = (const f32x4*)(a.in[0] + (size_t)rowB * 2048) + lane;
    const f32x4* g1 = (const f32x4*)a.in[22] + lane; const f32x4* g2 = (const f32x4*)a.in[23] + lane;
    f32x4 v[8], w[8]; v2u ma[8], mb_[8];
#pragma unroll
    for (int jj = 0; jj < 8; ++jj) { v[jj] = xA[64 * jj]; w[jj] = xB[64 * jj]; ma[jj] = mbA[64 * jj]; mb_[jj] = mbB[64 * jj]; }
#pragma unroll
    for (int o = 1; o < 64; o <<= 1) { sa += __shfl_xor(sa, o); sb += __shfl_xor(sb, o); }
    const float ra = 1.f / sqrtf(sa * (1.f / DMODEL) + RMS_EPS), rb = 1.f / sqrtf(sb * (1.f / DMODEL) + RMS_EPS);
    float s = 0.f, t = 0.f;
#pragma unroll
    for (int jj = 0; jj < 8; ++jj) { const f32x4 gg = g1[64 * jj]; v[jj] = v[jj] + bf4(ma[jj]) * ra * gg; w[jj] = w[jj] + bf4(mb_[jj]) * rb * gg;
        s += (v[jj].x * v[jj].x + v[jj].y * v[jj].y) + (v[jj].z * v[jj].z + v[jj].w * v[jj].w); t += (w[jj].x * w[jj].x + w[jj].y * w[jj].y) + (w[jj].z * w[jj].z + w[jj].w * w[jj].w); }
#pragma unroll
    for (int o = 1; o < 64; o <<= 1) { s += __shfl_xor(s, o); t += __shfl_xor(t, o); }
    const float r0 = 1.f / sqrtf(s * (1.f / DMODEL) + RMS_EPS), r1 = 1.f / sqrtf(t * (1.f / DMODEL) + RMS_EPS);
    f32x4* oA = (f32x4*)(a.out + (size_t)rowA * 2048) + lane; f32x4* oB = (f32x4*)(a.out + (size_t)rowB * 2048) + lane;
    v2u* nA = (v2u*)((bf16*)(a.ws + WS_XN) + (size_t)rowA * 2048) + lane; v2u* nB = (v2u*)((bf16*)(a.ws + WS_XN) + (size_t)rowB * 2048) + lane;
#pragma unroll
    for (int jj = 0; jj < 8; ++jj) { const f32x4 gg = g2[64 * jj]; oA[64 * jj] = v[jj]; oB[64 * jj] = w[jj]; nA[64 * jj] = pk4(v[jj] * r0 * gg); nB[64 * jj] = pk4(w[jj] * r1 * gg); }
}

__global__ void __launch_bounds__(NTHR, 2) hybrid_fwd(Args args) {
    extern __shared__ __attribute__((aligned(16))) unsigned char lds[];
    Frame F; F.lds = (LAS unsigned char*)lds; F.wave = __builtin_amdgcn_readfirstlane(threadIdx.x >> 6);
    F.G = gridDim.x; F.gw = blockIdx.x * NWAVES + F.wave; F.NGW = F.G * NWAVES;
    unsigned char* ws = args.ws;
    volatile LAS unsigned* MISC = (volatile LAS unsigned*)(F.lds + MISC_OFF);
    unsigned* ctl = (unsigned*)(ws + WS_CTL);
    { int l_ = lane_id(); if (F.wave == 0 && l_ < 32) MISC[l_] = 0u; }
    __syncthreads();
    cg::this_grid().sync();
    XcdBarrier bar;
    { int l_ = lane_id(); bar = xcd_barrier_post(ctl + 4096, MISC + 8, F.wave * 64 + l_); }
#define GRID_BAR() do { int l_ = lane_id(); asm volatile("" : "+v"(l_)); xcd_barrier(bar, F.wave * 64 + l_); } while (0)

    PHASE_BEGIN();
    p0_prologue(F, args);
    GRID_BAR();
    {   pg8::Gemm g{(const pg8::bf16_t*)(ws + WS_XN), (const pg8::bf16_t*)(ws + WS_WIN), M, NPAD, DMODEL}; pg8::StaticOrder S; S.init(M, NPAD, F.G, (int)blockIdx.x);
        pg8::EpiZ E{(pg8::bf16_t*)(ws + WS_ZA), (pg8::bf16_t*)(ws + WS_ZB), (float*)(ws + WS_ZS)};
        pg8::gemm_phase<pg8::EpiZ, pg8::StaticOrder, PG8_ALIGN, PG8_SP2>(F.lds, g, S, E, F.wave); }
    GRID_BAR();
    PHASE_BEGIN();
    for (int g = blockIdx.x; g < T / 64; g += F.G) p2a_fgroup(F, args, g);
    GRID_BAR();
    PHASE_BEGIN();
    {   for (int g = blockIdx.x; g < T / 64; g += F.G) p2b_fgroup(F, args, g);
        for (int m = F.gw; m < M; m += F.NGW) p2_qknorm_row(args, m, F.lane);
        for (int tile = blockIdx.x; tile < T / 32; tile += F.G) p2_rwprep_tile(F, args, tile * 32); }
    GRID_BAR();
    PHASE_BEGIN();
    {   if ((int)blockIdx.x < NRWB) p3_rwkv_state(F, args);
        const attn_body::bf16* ZBq = (const attn_body::bf16*)(ws + WS_ZB); attn_body::bf16* Yo = (attn_body::bf16*)(ws + WS_XN) + 1024; const float* F2 = (const float*)(ws + WS_F2);
        float gapB; { const float bq = fabsf(args.in[19][F.lane]), bk = fabsf(args.in[20][F.lane]); float mq = bq, mk = bk;
#pragma unroll
            for (int o = 1; o < 64; o <<= 1) { mq = fmaxf(mq, __shfl_xor(mq, o)); mk = fmaxf(mk, __shfl_xor(mk, o)); }
            const float gv_ = 2.f * (64.f * mq * mk * 0.125f * LOG2E * 1.03f) + 48.f; asm volatile("v_readfirstlane_b32 %0, %1" : "=s"(gapB) : "v"(gv_)); }
        for (;;) {
            if (F.wave == 0) {
                const int ln_ = lane_id(); unsigned uu = 0u; if (ln_ == 0) uu = atomicAdd(ctl + 64, 1u);
                uu = (unsigned)__builtin_amdgcn_readfirstlane((int)uu);
                int tsw = 0;
                if (uu < (unsigned)(NH * (T / 256))) { const int qb_ = (T / 256 - 1) - (int)(uu >> 4), h_ = (int)(uu & 15);
                    const unsigned* F2h = (const unsigned*)(F2 + (size_t)h_ * T); const float lim = __uint_as_float(__hip_atomic_load(F2h + qb_ * 256, __ATOMIC_RELAXED, __HIP_MEMORY_SCOPE_AGENT)) + gapB; const int ntf = 4 * qb_;
                    for (int i = 0; i < 4; ++i) { const int jt = ln_ + 64 * i; const bool c = (jt < ntf) && (__uint_as_float(__hip_atomic_load(F2h + 64 * jt + 63, __ATOMIC_RELAXED, __HIP_MEMORY_SCOPE_AGENT)) >= lim); tsw += __popcll(__ballot(c)); }
                    tsw &= ~1; }
                if (ln_ == 0) { MISC[0] = uu; MISC[1] = (unsigned)tsw; }
            }
            __syncthreads();
            const unsigned u = (unsigned)__builtin_amdgcn_readfirstlane((int)MISC[0]); const int ts = __builtin_amdgcn_readfirstlane((int)MISC[1]);
            __syncthreads();
            if (u >= (unsigned)(NH * (T / 256))) break;
            const int qb = (T / 256 - 1) - (int)(u >> 4), h = (int)(u & 15);
            attn_body::attn_unit<8>(h, qb, ZBq, ZBq + 1024, ZBq + 2048, ZBq + 3072, Yo, F2 + (size_t)h * T, (char*)lds, F.wave, ts);
        } }
    GRID_BAR();
    PHASE_BEGIN();
    for (int ch = F.gw; ch < (T / 16) * NH; ch += F.NGW) p3_gn_chunk(args, ch, F.lane);
    GRID_BAR();
    {   pg8::Gemm g{(const pg8::bf16_t*)(ws + WS_XN), (const pg8::bf16_t*)(ws + WS_WOUT), M, DMODEL, DMODEL}; pg8::StaticOrder S; S.init(M, DMODEL, F.G, (int)blockIdx.x);
        pg8::EpiM E{(pg8::bf16_t*)(ws + WS_MB), (float*)(ws + WS_SSQ)};
        pg8::gemm_phase<pg8::EpiM, pg8::StaticOrder, PG8_ALIGN, PG8_SP2>(F.lds, g, S, E, F.wave); }
    GRID_BAR();
    PHASE_BEGIN();
    for (int m = F.gw; m < M; m += 2 * F.NGW) p5_row2(args, m, m + F.NGW, F.lane);
    GRID_BAR();
    {   pg8::Gemm g{(const pg8::bf16_t*)(ws + WS_PB), (const pg8::bf16_t*)(ws + WS_WPLE), M, DMODEL, DPLE}; pg8::StaticOrder S; S.init(M, DMODEL, F.G, (int)blockIdx.x);
        pg8::EpiBf16<0> E{(pg8::bf16_t*)(ws + WS_PLE), DMODEL, nullptr, 0, 0, 1.f};
        pg8::gemm_phase<pg8::EpiBf16<0>, pg8::StaticOrder, PG8_ALIGN, PG8_SP2>(F.lds, g, S, E, F.wave); }
    asm volatile("s_waitcnt vmcnt(0)" ::: "memory"); __syncthreads();
    {   pg8::Gemm g{(const pg8::bf16_t*)(ws + WS_XN), (const pg8::bf16_t*)(ws + WS_WGATE), M, DMODEL, DMODEL}; pg8::StaticOrder S; S.init(M, DMODEL, F.G, (int)blockIdx.x);
        pg8::EpiFinal E{args.out, (const pg8::bf16_t*)(ws + WS_PLE)};
        pg8::gemm_phase<pg8::EpiFinal, pg8::StaticOrder, PG8_ALIGN, PG8_SP2>(F.lds, g, S, E, F.wave); }
}

extern "C" void kernel_launch(void* const* d_in, const int* in_sizes, int n_in, void* d_out, int out_size, void* d_ws, size_t ws_size, hipStream_t stream) {
    static int grid = 0;
    if (grid == 0) {
        if (n_in != 26 || in_sizes[0] != M * DMODEL || out_size != M * DMODEL || ws_size < WS_END) { fprintf(stderr, "kernel_launch: unexpected shapes (n_in %d, in0 %d, out %d, ws %zu)\n", n_in, n_in > 0 ? in_sizes[0] : -1, out_size, ws_size); grid = -1; return; }
        int dev = 0, cus = 0, per_cu = 0;
        if (hipGetDevice(&dev) != hipSuccess || hipDeviceGetAttribute(&cus, hipDeviceAttributeMultiprocessorCount, dev) != hipSuccess) { grid = -1; return; }
        if (hipFuncSetAttribute((const void*)hybrid_fwd, hipFuncAttributeMaxDynamicSharedMemorySize, LDS_BYTES) != hipSuccess) { fprintf(stderr, "kernel_launch: hipFuncSetAttribute failed\n"); grid = -1; return; }
        if (hipOccupancyMaxActiveBlocksPerMultiprocessor(&per_cu, (const void*)hybrid_fwd, NTHR, LDS_BYTES) != hipSuccess || per_cu < 1) { fprintf(stderr, "kernel_launch: occupancy query says %d\n", per_cu); (void)hipGetLastError(); grid = -1; return; }
        grid = cus * per_cu;
        if (grid < NRWB) { fprintf(stderr, "kernel_launch: grid %d too small\n", grid); grid = -1; return; }
    }
    if (grid < 0) return;
    (void)hipMemsetAsync((char*)d_ws + WS_CTL, 0, 65536, stream);
    Args a{};
    for (int i = 0; i < 26; ++i) a.in[i] = (const float*)d_in[i];
    a.out = (float*)d_out; a.ws = (unsigned char*)d_ws;
    void* kargs[] = {&a};
    hipError_t e = hipLaunchCooperativeKernel((const void*)hybrid_fwd, dim3(grid), dim3(NTHR), kargs, LDS_BYTES, stream);
    if (e != hipSuccess) fprintf(stderr, "kernel_launch: cooperative launch failed: %s (grid %d)\n", hipGetErrorString(e), grid);
}
```

```cpp
#include <hip/hip_runtime.h>
#include <hip/hip_cooperative_groups.h>
#include <cstdio>
#include <cstdint>
namespace pg8 {
#define PG8_LAS __attribute__((address_space(3)))
typedef unsigned short bf16_t;
typedef short bf16x8 __attribute__((ext_vector_type(8)));
typedef float f32x4 __attribute__((ext_vector_type(4)));
typedef unsigned u32x4 __attribute__((ext_vector_type(4)));
constexpr int BM = 256, BK = 64, HALF = 128, HTB = HALF * BK * 2  , STAGE_BYTES = 8 * HTB, NXCD = 8, WGM = 8;

__host__ __device__ __forceinline__ int lds_byte(int r, int c) { const int st = (r >> 4) * 2 + (c >> 5), rr = r & 15, cc = c & 31, ob = rr * 64 + cc * 2; return st * 1024 + (ob ^ (((ob >> 9) & 1) << 5)); }
__host__ __device__ __forceinline__ void stage_rc(int b, int& R, int& C) { const int st = b / 1024, sb = b % 1024, swz = sb ^ (((sb >> 9) & 1) << 5); R = (st >> 1) * 16 + swz / 64; C = (st & 1) * 32 + (swz % 64) / 2; }
__host__ __device__ __forceinline__ int perm32(int rho) { const int n = rho >> 4, i = rho & 15; return 8 * (i >> 2) + 4 * n + (i & 3); }

struct Unit { int pm, pn; };
struct Gemm { const bf16_t* A; const bf16_t* Bt; int M, N, K; };

struct StaticOrder {
    int nM, nN, nwg, G, c;
    __host__ __device__ void init(int M, int N, int G_, int c_) { nM = M / BM; nN = N / BM; nwg = nM * nN; G = G_; c = c_; }
    __host__ __device__ bool next(int i, Unit& u) const {
        const long L = (long)i * G + c; if (L >= nwg) return false;
        int wgid = (int)L; { const int q = nwg / NXCD, r = nwg % NXCD, xcd = wgid % NXCD, off = wgid / NXCD; wgid = (xcd < r ? xcd * (q + 1) : r * (q + 1) + (xcd - r) * q) + off; }
        const int nig = WGM * nN, gid = wgid / nig, fm = gid * WGM, gsz = (nM - fm) < WGM ? (nM - fm) : WGM;
        u.pm = fm + ((wgid % nig) % gsz); u.pn = (wgid % nig) / gsz; return true;
    }
    __device__ __forceinline__ void a_ready(const Unit&) const {}
    __device__ __forceinline__ void done(const Unit&) const {}
};

__device__ __forceinline__ unsigned cvt_pk_bf16(float lo, float hi) { unsigned r; asm volatile("v_cvt_pk_bf16_f32 %0, %1, %2" : "=v"(r) : "v"(lo), "v"(hi)); return r; }
typedef float f32x2 __attribute__((ext_vector_type(2)));
__device__ __forceinline__ f32x2 gelu_pk(f32x2 v) {
    const f32x2 av = __builtin_elementwise_abs(v), d = av * 0.2316418882f + 1.0f;
    f32x2 t; t.x = __builtin_amdgcn_rcpf(d.x); t.y = __builtin_amdgcn_rcpf(d.y);
    f32x2 q = t * 0.5307027145f + (-0.7265760135f); q = q * t + 0.7107068705f; q = q * t + (-0.142248368f); q = q * t + 0.127414796f; q = q * t;
    const f32x2 s = (v * v) * (-0.72134752044f);
    f32x2 e; e.x = __builtin_amdgcn_exp2f(s.x); e.y = __builtin_amdgcn_exp2f(s.y);
    const f32x2 m = v * (q * e), r = v - m;
    f32x2 o; o.x = v.x < 0.f ? m.x : r.x; o.y = v.y < 0.f ? m.y : r.y; return o;
}

template <int ACT  > struct EpiBf16 {
    static constexpr bool PERM = true, AFTER_DRAIN = false; static_assert(ACT == 0 || ACT == 1, "EpiBf16: ACT is 0 (none) or 1 (gelu_pk)");
    bf16_t* O; int ldc; const float* bias; int split_cols; size_t split_stride; float scale0;
    __device__ __forceinline__ void operator()(const f32x4 (&acc)[2][2][4][2], const Unit& u, int wr, int wc, int fr, int fq) const {
        const int row0 = u.pm * BM + wr * 64 + fr; int colt = u.pn * BM; bf16_t* base = O;
        float sc = 1.f; if (split_cols) { const int t = colt / split_cols; base += (size_t)t * split_stride; colt -= t * split_cols; if (t == 0) sc = scale0; }
        const int col0 = colt + wc * 32 + 8 * fq, bcol0 = u.pn * BM + wc * 32 + 8 * fq;
        f32x4 bv[2][2];
#pragma unroll
        for (int bj = 0; bj < 2; ++bj)
#pragma unroll
            for (int n = 0; n < 2; ++n) bv[bj][n] = bias ? *(const f32x4*)(bias + bcol0 + bj * HALF + 4 * n) : (f32x4){0.f, 0.f, 0.f, 0.f};
#pragma unroll
        for (int ai = 0; ai < 2; ++ai)
#pragma unroll
            for (int m = 0; m < 4; ++m) { bf16_t* rowp = base + (size_t)(row0 + ai * HALF + m * 16) * ldc + col0;
#pragma unroll
                for (int bj = 0; bj < 2; ++bj) { f32x4 v0 = acc[ai][bj][m][0] + bv[bj][0], v1 = acc[ai][bj][m][1] + bv[bj][1];
                    if (ACT == 1) { f32x2 a = gelu_pk((f32x2){v0[0], v0[1]}), b = gelu_pk((f32x2){v0[2], v0[3]}), c = gelu_pk((f32x2){v1[0], v1[1]}), d = gelu_pk((f32x2){v1[2], v1[3]});
                        v0 = (f32x4){a.x, a.y, b.x, b.y}; v1 = (f32x4){c.x, c.y, d.x, d.y}; }
                    v0 = v0 * sc; v1 = v1 * sc; u32x4 w; w.x = cvt_pk_bf16(v0[0], v0[1]); w.y = cvt_pk_bf16(v0[2], v0[3]); w.z = cvt_pk_bf16(v1[0], v1[1]); w.w = cvt_pk_bf16(v1[2], v1[3]);
                    *(u32x4*)(rowp + bj * HALF) = w; } }
    }
};
template <class Epi, class Sched, bool ALIGN_EPI = false, bool SP2 = false>
__device__ __forceinline__ void gemm_phase(PG8_LAS unsigned char* lds, const Gemm g, const Sched& S, const Epi& E, const int wave_) {
    int tid_ = wave_ * 64 + ({ int l__; asm volatile("v_mbcnt_lo_u32_b32 %0, -1, 0\n\tv_mbcnt_hi_u32_b32 %0, -1, %0" : "=v"(l__)); l__; }); asm volatile("" : "+v"(tid_));
    const int tid = tid_, wid = __builtin_amdgcn_readfirstlane(tid >> 6), lane = tid & 63, wr = wid >> 2, wc = wid & 3, fr = lane & 15, fq = lane >> 4;
    const int K = g.K, nt = K / BK;
    unsigned voffA[2], voffB[2];
#pragma unroll
    for (int i = 0; i < 2; ++i) { int R, C; stage_rc(tid * 16 + i * 8192, R, C); const int Rb = Epi::PERM ? ((R & ~31) + perm32(R & 31)) : R;
        voffA[i] = (unsigned)(R * K + C) * 2u; voffB[i] = (unsigned)(Rb * K + C) * 2u; }
    const size_t kstep = (size_t)(BK * 2);
    const size_t hstep = (size_t)HALF * K * 2;
    const size_t tstep = 2 * hstep;
    const unsigned ldsw = (unsigned)wid * 1024u;
    const int aoff = lds_byte(wr * 64 + fr, fq * 8), boff = lds_byte(wc * 32 + fr, fq * 8);
#define PG8_SA(b, h) (((b) * 2 + (h)) * HTB)
#define PG8_SB(b, h) ((4 + (b) * 2 + (h)) * HTB)
#define PG8_STAGE(bufoff, gbase, voff) do { _Pragma("unroll") for (int _i = 0; _i < 2; ++_i) \
        __builtin_amdgcn_global_load_lds((const unsigned*)((const char*)(gbase) + (voff)[_i]), (PG8_LAS unsigned*)(lds + (bufoff) + ldsw + _i * 8192), 16, 0, 0); } while (0)
#define PG8_LDA(dst, b, h) do { _Pragma("unroll") for (int m = 0; m < 4; ++m) _Pragma("unroll") for (int k = 0; k < 2; ++k) dst[m][k] = *(const PG8_LAS bf16x8*)(lds + PG8_SA(b, h) + aoff + m * 2048 + k * 1024); } while (0)
#define PG8_LDB(dst, b, h) do { _Pragma("unroll") for (int n = 0; n < 2; ++n) _Pragma("unroll") for (int k = 0; k < 2; ++k) dst[n][k] = *(const PG8_LAS bf16x8*)(lds + PG8_SB(b, h) + boff + n * 2048 + k * 1024); } while (0)
#define PG8_MMA(ai, bj, At, Bt) do { __builtin_amdgcn_s_setprio(1); _Pragma("unroll") for (int m = 0; m < 4; ++m) _Pragma("unroll") for (int n = 0; n < 2; ++n) _Pragma("unroll") for (int k = 0; k < 2; ++k) \
        acc[ai][bj][m][n] = __builtin_amdgcn_mfma_f32_16x16x32_bf16(Bt[n][k], At[m][k], acc[ai][bj][m][n], 0, 0, 0); __builtin_amdgcn_s_setprio(0); } while (0)
#define PG8_WAIT_V(n) asm volatile("s_waitcnt vmcnt(" #n ")" ::: "memory")
#define PG8_WAIT_L(n) asm volatile("s_waitcnt lgkmcnt(" #n ")" ::: "memory")
#define PG8_BAR __builtin_amdgcn_s_barrier()
#define PG8_SCHED __builtin_amdgcn_sched_barrier(0)
    Unit cur, nxt; int ui = 0;
    if (!S.next(0, cur)) return;
    f32x4 acc[2][2][4][2];
#pragma unroll
    for (int a = 0; a < 2; ++a)
#pragma unroll
        for (int b = 0; b < 2; ++b)
#pragma unroll
            for (int m = 0; m < 4; ++m)
#pragma unroll
                for (int n = 0; n < 2; ++n) acc[a][b][m][n] = (f32x4){0.f, 0.f, 0.f, 0.f};
    bf16x8 At[4][2], B0[2][2], B1[2][2];
    const char* cA = (const char*)g.A + (size_t)cur.pm * tstep; const char* cB = (const char*)g.Bt + (size_t)cur.pn * tstep;
    S.a_ready(cur);
    if constexpr (SP2) {
        PG8_STAGE(PG8_SB(0, 0), cB, voffB); PG8_STAGE(PG8_SB(0, 1), cB + hstep, voffB); PG8_STAGE(PG8_SA(0, 0), cA, voffA); PG8_STAGE(PG8_SA(0, 1), cA + hstep, voffA);
        if (wr == 1) PG8_BAR;
        PG8_WAIT_V(2); PG8_BAR;
        PG8_STAGE(PG8_SB(1, 0), cB + kstep, voffB); PG8_STAGE(PG8_SA(1, 0), cA + kstep, voffA); PG8_STAGE(PG8_SB(1, 1), cB + hstep + kstep, voffB);
        PG8_WAIT_V(6); PG8_BAR;
    } else {
        PG8_STAGE(PG8_SB(0, 0), cB, voffB); PG8_STAGE(PG8_SA(0, 0), cA, voffA); PG8_STAGE(PG8_SB(0, 1), cB + hstep, voffB); PG8_STAGE(PG8_SA(0, 1), cA + hstep, voffA);
        if (wr == 1) PG8_BAR;
        PG8_WAIT_V(4); PG8_BAR;
        PG8_STAGE(PG8_SB(1, 0), cB + kstep, voffB); PG8_STAGE(PG8_SA(1, 0), cA + kstep, voffA); PG8_STAGE(PG8_SB(1, 1), cB + hstep + kstep, voffB);
        PG8_WAIT_V(6); PG8_BAR;
    }
    for (;;) {
        const bool has_next = S.next(ui + 1, nxt);
        const char* nA = has_next ? (const char*)g.A + (size_t)nxt.pm * tstep : cA; const char* nB = has_next ? (const char*)g.Bt + (size_t)nxt.pn * tstep : cB;
        for (int t = 0; t < nt; t += 2) {
            const bool last = (t == nt - 2);
            const char* a1 = cA + (size_t)(t + 1) * kstep;
            const char* a2 = last ? nA : cA + (size_t)(t + 2) * kstep; const char* b2 = last ? nB : cB + (size_t)(t + 2) * kstep;
            const char* a3 = a2 + kstep; const char* b3 = b2 + kstep;
            if (last && has_next) S.a_ready(nxt);
            if constexpr (SP2) {
            PG8_LDB(B0, 0, 0); PG8_LDB(B1, 0, 1); PG8_SCHED; PG8_LDA(At, 0, 0); PG8_STAGE(PG8_SA(1, 1), a1 + hstep, voffA);
            PG8_WAIT_V(8); PG8_WAIT_L(0); PG8_BAR; PG8_MMA(0, 0, At, B0); PG8_MMA(0, 1, At, B1); PG8_BAR; PG8_SCHED;
            PG8_LDA(At, 0, 1); PG8_STAGE(PG8_SB(0, 0), b2, voffB); PG8_STAGE(PG8_SB(0, 1), b2 + hstep, voffB); PG8_STAGE(PG8_SA(0, 0), a2, voffA);
            PG8_WAIT_V(8); PG8_WAIT_L(0); PG8_BAR; PG8_MMA(1, 0, At, B0); PG8_MMA(1, 1, At, B1); PG8_BAR; PG8_SCHED;
            PG8_LDB(B0, 1, 0); PG8_LDB(B1, 1, 1); PG8_SCHED; PG8_LDA(At, 1, 0); PG8_STAGE(PG8_SA(0, 1), a2 + hstep, voffA);
            PG8_WAIT_V(8); PG8_WAIT_L(0); PG8_BAR; PG8_MMA(0, 0, At, B0); PG8_MMA(0, 1, At, B1); PG8_BAR; PG8_SCHED;
            PG8_LDA(At, 1, 1); PG8_STAGE(PG8_SB(1, 0), b3, voffB); PG8_STAGE(PG8_SB(1, 1), b3 + hstep, voffB); PG8_STAGE(PG8_SA(1, 0), a3, voffA);
            PG8_WAIT_V(8); PG8_WAIT_L(0); PG8_BAR; PG8_MMA(1, 0, At, B0); PG8_MMA(1, 1, At, B1); PG8_BAR; PG8_SCHED;
            } else {
            PG8_LDB(B0, 0, 0); PG8_SCHED; PG8_LDA(At, 0, 0); PG8_STAGE(PG8_SA(1, 1), a1 + hstep, voffA);
            PG8_WAIT_L(8); PG8_BAR; PG8_WAIT_L(0); PG8_MMA(0, 0, At, B0); PG8_BAR; PG8_SCHED;
            PG8_LDB(B1, 0, 1); PG8_STAGE(PG8_SB(0, 0), b2, voffB);
            PG8_BAR; PG8_WAIT_L(0); PG8_MMA(0, 1, At, B1); PG8_BAR;
            PG8_LDA(At, 0, 1); PG8_STAGE(PG8_SA(0, 0), a2, voffA);
            PG8_BAR; PG8_WAIT_L(0); PG8_MMA(1, 0, At, B0); PG8_BAR; PG8_SCHED;
            PG8_STAGE(PG8_SB(0, 1), b2 + hstep, voffB);
            PG8_WAIT_V(6); PG8_BAR; PG8_MMA(1, 1, At, B1); PG8_BAR;
            PG8_LDB(B0, 1, 0); PG8_SCHED; PG8_LDA(At, 1, 0); PG8_STAGE(PG8_SA(0, 1), a2 + hstep, voffA);
            PG8_WAIT_L(8); PG8_BAR; PG8_WAIT_L(0); PG8_MMA(0, 0, At, B0); PG8_BAR; PG8_SCHED;
            PG8_LDB(B1, 1, 1); PG8_STAGE(PG8_SB(1, 0), b3, voffB);
            PG8_BAR; PG8_WAIT_L(0); PG8_MMA(0, 1, At, B1); PG8_BAR;
            PG8_LDA(At, 1, 1); PG8_STAGE(PG8_SA(1, 0), a3, voffA);
            PG8_BAR; PG8_WAIT_L(0); PG8_MMA(1, 0, At, B0); PG8_BAR; PG8_SCHED;
            PG8_STAGE(PG8_SB(1, 1), b3 + hstep, voffB);
            PG8_WAIT_V(6); PG8_BAR; PG8_MMA(1, 1, At, B1); PG8_BAR;
            }
        }
        if constexpr (ALIGN_EPI) { if (wr == 0) PG8_BAR; }
        if constexpr (!Epi::AFTER_DRAIN) { int l_; asm volatile("v_mbcnt_lo_u32_b32 %0, -1, 0\n\tv_mbcnt_hi_u32_b32 %0, -1, %0" : "=v"(l_));
            E(acc, cur, wr, wc, l_ & 15, l_ >> 4); S.done(cur); }
        if (!has_next) break;
#pragma unroll
        for (int a = 0; a < 2; ++a)
#pragma unroll
            for (int b = 0; b < 2; ++b)
#pragma unroll
                for (int m = 0; m < 4; ++m)
#pragma unroll
                    for (int n = 0; n < 2; ++n) acc[a][b][m][n] = (f32x4){0.f, 0.f, 0.f, 0.f};
        cur = nxt; cA = nA; cB = nB; ++ui;
        if constexpr (ALIGN_EPI) { if (wr == 1) PG8_BAR; }
    }
    PG8_WAIT_V(0);
    if constexpr (!ALIGN_EPI) { if (wr == 0) PG8_BAR; }
    PG8_BAR;
    if constexpr (Epi::AFTER_DRAIN) { E.fused(acc, cur, wr, wc, fr, fq, lds, wid, lane); S.done(cur); }
#undef PG8_SA
#undef PG8_SB
#undef PG8_STAGE
#undef PG8_LDA
#undef PG8_LDB
#undef PG8_MMA
#undef PG8_WAIT_V
#undef PG8_WAIT_L
#undef PG8_BAR
#undef PG8_SCHED
}
}

#ifndef PG8_SP2
#define PG8_SP2 true
#endif
#ifndef PG8_ALIGN
#define PG8_ALIGN true
#endif
namespace pg8 {
struct EpiZ {
    static constexpr bool PERM = true, AFTER_DRAIN = false;
    bf16_t* ZA; bf16_t* ZB; float* ZS;
    __device__ __forceinline__ void operator()(const f32x4 (&acc)[2][2][4][2], const Unit& u, int wr, int wc, int fr, int fq) const {
        const int row0 = u.pm * BM + wr * 64 + fr; const int colt = u.pn * BM; const int cl = wc * 32 + 8 * fq;
        if (colt >= 8192) {
#pragma unroll
            for (int ai = 0; ai < 2; ++ai)
#pragma unroll
                for (int m = 0; m < 4; ++m) { float* rowp = ZS + (size_t)(row0 + ai * HALF + m * 16) * 256 + cl;
#pragma unroll
                    for (int bj = 0; bj < 2; ++bj) { *(f32x4*)(rowp + bj * HALF) = acc[ai][bj][m][0]; *(f32x4*)(rowp + bj * HALF + 4) = acc[ai][bj][m][1]; } }
        } else {
            bf16_t* base; int ldc, c0; if (colt < 3072) { base = ZA; ldc = 3072; c0 = colt; } else { base = ZB; ldc = 5120; c0 = colt - 3072; }
#pragma unroll
            for (int ai = 0; ai < 2; ++ai)
#pragma unroll
                for (int m = 0; m < 4; ++m) { bf16_t* rowp = base + (size_t)(row0 + ai * HALF + m * 16) * ldc + c0 + cl;
#pragma unroll
                    for (int bj = 0; bj < 2; ++bj) { const f32x4 v0 = acc[ai][bj][m][0], v1 = acc[ai][bj][m][1]; u32x4 w; w.x = cvt_pk_bf16(v0[0], v0[1]); w.y = cvt_pk_bf16(v0[2], v0[3]); w.z = cvt_pk_bf16(v1[0], v1[1]); w.w = cvt_pk_bf16(v1[2], v1[3]);
                        *(u32x4*)(rowp + bj * HALF) = w; } }
        }
    }
};
struct EpiM {
    static constexpr bool PERM = true, AFTER_DRAIN = false;
    bf16_t* O; float* SSQ;
    __device__ __forceinline__ void operator()(const f32x4 (&acc)[2][2][4][2], const Unit& u, int wr, int wc, int fr, int fq) const {
        const int row0 = u.pm * BM + wr * 64 + fr; const int col0 = u.pn * BM + wc * 32 + 8 * fq;
#pragma unroll
        for (int ai = 0; ai < 2; ++ai)
#pragma unroll
            for (int m = 0; m < 4; ++m) { const int row = row0 + ai * HALF + m * 16; bf16_t* rowp = O + (size_t)row * 2048 + col0; float s = 0.f;
#pragma unroll
                for (int bj = 0; bj < 2; ++bj) { const f32x4 v0 = acc[ai][bj][m][0], v1 = acc[ai][bj][m][1];
                    s += (v0[0] * v0[0] + v0[1] * v0[1]) + (v0[2] * v0[2] + v0[3] * v0[3]) + (v1[0] * v1[0] + v1[1] * v1[1]) + (v1[2] * v1[2] + v1[3] * v1[3]);
                    u32x4 w; w.x = cvt_pk_bf16(v0[0], v0[1]); w.y = cvt_pk_bf16(v0[2], v0[3]); w.z = cvt_pk_bf16(v1[0], v1[1]); w.w = cvt_pk_bf16(v1[2], v1[3]);
                    *(u32x4*)(rowp + bj * HALF) = w; }
                s += __shfl_xor(s, 16); s += __shfl_xor(s, 32);
                if (fq == 0) SSQ[(size_t)row * 32 + u.pn * 4 + wc] = s; }
    }
};
struct EpiFinal {
    static constexpr bool PERM = true, AFTER_DRAIN = false;
    float* OUT; const bf16_t* PLE;
    __device__ __forceinline__ void operator()(const f32x4 (&acc)[2][2][4][2], const Unit& u, int wr, int wc, int fr, int fq) const {
        const int row0 = u.pm * BM + wr * 64 + fr; const int col0 = u.pn * BM + wc * 32 + 8 * fq;
#pragma unroll
        for (int ai = 0; ai < 2; ++ai)
#pragma unroll
            for (int m = 0; m < 4; ++m) { const size_t off = (size_t)(row0 + ai * HALF + m * 16) * 2048 + col0;
#pragma unroll
                for (int bj = 0; bj < 2; ++bj) { const f32x4 a0 = acc[ai][bj][m][0], a1 = acc[ai][bj][m][1];
                    const f32x4 x0 = *(const f32x4*)(OUT + off + bj * HALF), x1 = *(const f32x4*)(OUT + off + bj * HALF + 4); const u32x4 pl = *(const u32x4*)(PLE + off + bj * HALF);
                    f32x4 o0, o1;
#pragma unroll
                    for (int e = 0; e < 2; ++e) { const float pl0 = __uint_as_float(pl[e] << 16), pl1 = __uint_as_float(pl[e] & 0xffff0000u), ph0 = __uint_as_float(pl[2 + e] << 16), ph1 = __uint_as_float(pl[2 + e] & 0xffff0000u);
                        o0[2 * e] = x0[2 * e] + pl0 * __builtin_amdgcn_rcpf(1.f + __expf(-a0[2 * e])); o0[2 * e + 1] = x0[2 * e + 1] + pl1 * __builtin_amdgcn_rcpf(1.f + __expf(-a0[2 * e + 1]));
                        o1[2 * e] = x1[2 * e] + ph0 * __builtin_amdgcn_rcpf(1.f + __expf(-a1[2 * e])); o1[2 * e + 1] = x1[2 * e + 1] + ph1 * __builtin_amdgcn_rcpf(1.f + __expf(-a1[2 * e + 1])); }
                    *(f32x4*)(OUT + off + bj * HALF) = o0; *(f32x4*)(OUT + off + bj * HALF + 4) = o1; asm volatile("" ::: "memory"); } }
    }
};
}
#include <hip/hip_bf16.h>
#include <cmath>
namespace attn_body {
using bf16=__hip_bfloat16;
using bf16x8=__attribute__((ext_vector_type(8)))short;
using s16x4=__attribute__((ext_vector_type(4)))short;
using f32x16=__attribute__((ext_vector_type(16)))float;
using u32x4=__attribute__((ext_vector_type(4)))unsigned;
using f32x4v=__attribute__((ext_vector_type(4)))float;
constexpr int BATCH=1,NHEAD=16,SEQ=16384,D=64,DM=5120,PO=2048;
constexpr int NW=8,QBLK=32,QB=QBLK*NW,KVBLK=64,NQB=SEQ/QB;
constexpr int ATTN_PITCH=DM, ATTN_UNIT_ROWS=QB;
__device__ __forceinline__ int crow(int r,int hi){return (r&3)+8*(r>>2)+4*hi;}
#define SBAR() __builtin_amdgcn_sched_barrier(0)
__device__ __forceinline__ void cmask(f32x16&p0,f32x16&p1,int jb,int qrel,int hi){
  const float NEG=-INFINITY; int dq=qrel-(64*jb+4*hi); asm volatile("":"+v"(dq));
  #pragma unroll
  for(int r=0;r<16;++r){const int c=(r&3)+8*(r>>2); if(c>dq)p0[r]=NEG; if(c+32>dq)p1[r]=NEG;}
}

constexpr int NSLOT=3, SLOTB=8192;
constexpr int LDS_K=0, LDS_V=NSLOT*SLOTB, LDS_WS=2*NSLOT*SLOTB, LDS_OST=LDS_WS+NW*64*4, LDS_F=LDS_OST+NW*4096,LDS_BYTES=LDS_F+SEQ*4;
constexpr float C2=0.125f*1.4426950408889634f;
__device__ __forceinline__ void glds16(const void*gsrc,unsigned lds_dst){unsigned keep;
  asm volatile("s_mov_b32 %0, m0\n\ts_mov_b32 m0, %2\n\ts_nop 0\n\tglobal_load_lds_dwordx4 %1, off\n\ts_mov_b32 m0, %0":"=&s"(keep):"v"(gsrc),"s"(lds_dst):"memory");}
__device__ __forceinline__ float max3f(float a,float b,float c){float r;asm("v_max3_f32 %0, %1, %2, %3":"=v"(r):"v"(a),"v"(b),"v"(c));return r;}
__device__ __forceinline__ float max2f(float a,float b){float r;asm("v_max_f32_e32 %0, %1, %2":"=v"(r):"v"(a),"v"(b));return r;}
__device__ __forceinline__ float fadd_s(float a,float b){float r;asm("v_add_f32_e32 %0, %1, %2":"=v"(r):"v"(a),"v"(b));return r;}
__device__ __forceinline__ float fsub_s(float a,float b){float r;asm("v_sub_f32_e32 %0, %1, %2":"=v"(r):"v"(a),"v"(b));return r;}
typedef float f32x2_t __attribute__((ext_vector_type(2))); typedef __bf16 bf16x2_t __attribute__((ext_vector_type(2)));
__device__ __forceinline__ unsigned cvtpk_s(float lo,float hi){f32x2_t v={lo,hi};bf16x2_t b=__builtin_convertvector(v,bf16x2_t);return __builtin_bit_cast(unsigned,b);}
#define WAIT_BAR(N) asm volatile("s_waitcnt vmcnt(" #N ") lgkmcnt(0)\n\ts_barrier":::"memory")

__device__ __forceinline__ void qkt(f32x16&p0,f32x16&p1,const char*Kslot,const bf16x8*qr,int r32,int hi){
  const char*kb=Kslot+hi*1024+r32*16;
  #pragma unroll
  for(int d0=0;d0<4;++d0){
    const bf16x8 b0=*reinterpret_cast<const bf16x8*>(kb+d0*2048);
    const bf16x8 b1=*reinterpret_cast<const bf16x8*>(kb+d0*2048+512);
    {p0=__builtin_amdgcn_mfma_f32_32x32x16_bf16(b0,qr[d0],p0,0,0,0);p1=__builtin_amdgcn_mfma_f32_32x32x16_bf16(b1,qr[d0],p1,0,0,0);}}
}
typedef __attribute__((address_space(3))) const char* lds_cptr;
typedef short v4i16_t __attribute__((ext_vector_type(4)));
__device__ __forceinline__ void kload8(bf16x8*kf,lds_cptr kp){
  kf[0]=*(const __attribute__((address_space(3))) bf16x8*)(kp);      kf[1]=*(const __attribute__((address_space(3))) bf16x8*)(kp+512);
  kf[2]=*(const __attribute__((address_space(3))) bf16x8*)(kp+2048); kf[3]=*(const __attribute__((address_space(3))) bf16x8*)(kp+2560);
  kf[4]=*(const __attribute__((address_space(3))) bf16x8*)(kp+4096); kf[5]=*(const __attribute__((address_space(3))) bf16x8*)(kp+4608);
  kf[6]=*(const __attribute__((address_space(3))) bf16x8*)(kp+6144); kf[7]=*(const __attribute__((address_space(3))) bf16x8*)(kp+6656);
}
__device__ __forceinline__ void kload2(bf16x8*kf,lds_cptr kp,int j){ kf[2*j]=*(const __attribute__((address_space(3))) bf16x8*)(kp+j*2048); kf[2*j+1]=*(const __attribute__((address_space(3))) bf16x8*)(kp+j*2048+512); }
__device__ __forceinline__ s16x4 vtr(lds_cptr p){ return __builtin_bit_cast(s16x4,__builtin_amdgcn_ds_read_tr16_b64_v4i16((__attribute__((address_space(3))) v4i16_t*)p)); }
__device__ __forceinline__ float rowmax(const f32x16&p0,const f32x16&p1){
  float a=max3f(p0[0],p0[1],p1[0]),b=max3f(p0[2],p0[3],p1[1]);a=max3f(a,p1[2],p1[3]);
  #pragma unroll
  for(int r=4;r<16;r+=4){a=max3f(a,p0[r],p0[r+1]);b=max3f(b,p0[r+2],p0[r+3]);a=max3f(a,p1[r],p1[r+1]);b=max3f(b,p1[r+2],p1[r+3]);}
  const float m=max2f(a,b);
  auto rr=__builtin_amdgcn_permlane32_swap(__float_as_uint(m),__float_as_uint(m),false,false);
  return max2f(__uint_as_float(rr[0]),__uint_as_float(rr[1]));
}
__device__ __forceinline__ void pv(f32x16*o,int vb,bf16x8 pa0,bf16x8 pa1,bf16x8 pa2,bf16x8 pa3){
  #pragma unroll
  for(int d0=0;d0<2;++d0){s16x4 lo[4],hi[4];
    #pragma unroll
    for(int ks=0;ks<4;++ks){
      asm volatile("ds_read_b64_tr_b16 %0,%1 offset:%c2":"=&v"(lo[ks]):"v"(vb),"i"(d0*4096+ks*1024):"memory");
      asm volatile("ds_read_b64_tr_b16 %0,%1 offset:%c2":"=&v"(hi[ks]):"v"(vb),"i"(d0*4096+ks*1024+512):"memory");}
    asm volatile("s_waitcnt lgkmcnt(0)":::"memory");SBAR();
    #define PK(k) (bf16x8){lo[k][0],lo[k][1],lo[k][2],lo[k][3],hi[k][0],hi[k][1],hi[k][2],hi[k][3]}
    o[d0]=__builtin_amdgcn_mfma_f32_32x32x16_bf16(pa0,PK(0),o[d0],0,0,0);
    o[d0]=__builtin_amdgcn_mfma_f32_32x32x16_bf16(pa1,PK(1),o[d0],0,0,0);
    o[d0]=__builtin_amdgcn_mfma_f32_32x32x16_bf16(pa2,PK(2),o[d0],0,0,0);
    o[d0]=__builtin_amdgcn_mfma_f32_32x32x16_bf16(pa3,PK(3),o[d0],0,0,0);
    #undef PK
  }
}

#ifndef ATTN_STORE16
#define ATTN_STORE16(p,v) (*(u32x4*)(p)=(v))
#endif
template<int THRL> __device__ __forceinline__ void attn_unit(int h,int qb,const bf16*Q,const bf16*__restrict__ K,const bf16*__restrict__ V,const bf16*__restrict__ G,bf16*O,const float*__restrict__ F2h,char*shm,const int wave_,const int ts){
  const int wid=wave_; int lane_=({ int l__; asm volatile("v_mbcnt_lo_u32_b32 %0, -1, 0\n\tv_mbcnt_hi_u32_b32 %0, -1, %0" : "=v"(l__)); l__; }); asm volatile("":"+v"(lane_)); const int lane=lane_,tid=wid*64+lane,r32=lane&31,hi=lane>>5;
  const long rowbase=0; const int q0=qb*QB;
  const bf16*Qw=Q+(rowbase+q0+wid*QBLK)*DM+h*D;
  const bf16*Kh=K+(long)ts*KVBLK*DM+h*D,*Vh=V+(long)ts*KVBLK*DM+h*D;
  const unsigned lds0=(unsigned)(uintptr_t)shm;
  float*wsf=(float*)(shm+LDS_WS)+wid*64;
  const bf16*ksrc=Kh+(long)lane*DM+wid*8;
  const bf16*vsrc=Vh+(long)(16*(wid&3)+(lane>>2))*DM+(wid>>2)*32+(lane&3)*8;
  const unsigned kdst=lds0+LDS_K+wid*1024, vdst=lds0+LDS_V+wid*1024;
  #define DMA_K(t,slot) glds16(ksrc+(long)(t)*KVBLK*DM,(unsigned)__builtin_amdgcn_readfirstlane(kdst+(slot)))
  #define DMA_V(t,slot) glds16(vsrc+(long)(t)*KVBLK*DM,(unsigned)__builtin_amdgcn_readfirstlane(vdst+(slot)))
  const int vb0=(int)(lds0+LDS_V)+((lane>>4)&1)*32+(lane&3)*8+(4*hi+((lane&15)>>2))*64;
  const char*Kbase=shm+LDS_K; bf16x8 kf[8];
  const lds_cptr shm3=(lds_cptr)shm; const lds_cptr kp0=shm3+LDS_K+hi*1024+r32*16; const lds_cptr vp0=shm3+LDS_V+((lane>>4)&1)*32+(lane&3)*8+(4*hi+((lane&15)>>2))*64;
  const int NT=(q0+QB)/KVBLK-ts;
  { typedef __attribute__((address_space(3))) f32x4v* lf4; const f32x4v*src=(const f32x4v*)(F2h+ts*KVBLK); lf4 dst=(lf4)((__attribute__((address_space(3))) char*)shm3+LDS_F); for(int i=tid;i<NT*16;i+=NW*64)dst[i]=src[i]; }
  const float fq2=F2h[q0+wid*QBLK+r32];
  asm volatile("s_waitcnt vmcnt(0) lgkmcnt(0)":::"memory");
  DMA_K(0,0);DMA_V(0,0);DMA_K(1,SLOTB);
  bf16x8 qr[4];
  #pragma unroll
  for(int d0=0;d0<4;++d0)qr[d0]=*reinterpret_cast<const bf16x8*>(&Qw[(long)r32*DM+d0*16+hi*8]);
  float fref=fq2  ,l_reg=0.f;f32x16 o[2];o[0]=f32x16{};o[1]=f32x16{};
  const int qrel=wid*QBLK+r32;
  typedef __attribute__((address_space(3))) const f32x4v* lds_f4c; const lds_f4c fbase=(lds_f4c)(shm3+LDS_F+16*hi);
  #define FLOAD(P0,P1,t) do{ const lds_f4c fp_=fbase+(t)*16; _Pragma("unroll") for(int j_=0;j_<4;++j_){ const f32x4v a_=fp_[2*j_], b_=fp_[8+2*j_]; \
      P0[4*j_]=a_[0];P0[4*j_+1]=a_[1];P0[4*j_+2]=a_[2];P0[4*j_+3]=a_[3]; P1[4*j_]=b_[0];P1[4*j_+1]=b_[1];P1[4*j_+2]=b_[2];P1[4*j_+3]=b_[3]; } }while(0)
  #define FSUB(P0,P1) do{ const float base_=fref; _Pragma("unroll") for(int r=0;r<16;++r){P0[r]=base_-P0[r];P1[r]=base_-P1[r];} }while(0)
  #define CMASK(P0,P1,t) do{int jb_=(t)-(NT-4); if(jb_>=0)cmask(P0,P1,jb_,qrel,hi);}while(0)
  bool resc=false;
  #define START(P0,P1) do{ const float rm=rowmax(P0,P1); resc=false; \
    { const float dl=rm; fref=fsub_s(fref,dl); \
      _Pragma("unroll") for(int r=0;r<16;++r){P0[r]=fsub_s(P0[r],dl);P1[r]=fsub_s(P1[r],dl);} \
      } \
    _Pragma("unroll") for(int r=0;r<16;++r)P0[r]=__builtin_amdgcn_exp2f(P0[r]); }while(0)
  #define RESC() do{ if(resc){ asm volatile("s_waitcnt lgkmcnt(0)":::"memory"); \
      _Pragma("unroll") for(int d_=0;d_<2;++d_) _Pragma("unroll") for(int r=0;r<16;++r)o[d_][r]*=wsf[crow(r,hi)]; } }while(0)
  f32x16 pA0,pA1,pB0,pB1;
  int sl_prev=0,sl_cur=0,sl_next=SLOTB;
  #define ROT() do{sl_prev=sl_cur;sl_cur=sl_next;sl_next=(sl_next==(NSLOT-1)*SLOTB)?0:sl_next+SLOTB;}while(0)
  DMA_K(2,2*SLOTB);
  WAIT_BAR(3);
  FLOAD(pA0,pA1,0); FSUB(pA0,pA1); qkt(pA0,pA1,Kbase,qr,r32,hi);asm volatile("s_nop 15\n\ts_nop 7":"+v"(pA0),"+v"(pA1));CMASK(pA0,pA1,0);
  START(pA0,pA1);
  _Pragma("unroll") for(int r=0;r<16;++r)pA1[r]=__builtin_amdgcn_exp2f(pA1[r]);
  WAIT_BAR(0);
  DMA_K(3,0);DMA_V(1,SLOTB);
  ROT();
  kload8(kf,kp0+sl_cur); FLOAD(pB0,pB1,1);
  WAIT_BAR(2);
  s16x4 vlo[8],vhi[8]; u32x4 pw0,pw1,pw2,pw3;
  #define PKW(P,B) cvtpk_s(P[B],P[B+1])
  #define PAF(k) __builtin_bit_cast(bf16x8,pw##k)
  #define VFR(i) (bf16x8){vlo[i][0],vlo[i][1],vlo[i][2],vlo[i][3],vhi[i][0],vhi[i][1],vhi[i][2],vhi[i][3]}
  #define PIN(x) asm volatile("":"+v"(x))
  #define MX3(a,b,c) __builtin_fmaxf(__builtin_fmaxf((a),(b)),(c))
  #define GAPA(MF,A0,A1,A2,A3,W0,W1,PW) do{ MF; sacc+=A0; sacc+=A1; sacc+=A2; sacc+=A3; PIN(sacc); W0; W1; PIN(PW); SBAR(); }while(0)
  #define EX(v) __builtin_amdgcn_exp2f(v)
  #define GAPB(MF,X,B) do{ MF; X[B]=EX(X[B]); X[B+1]=EX(X[B+1]); X[B+2]=EX(X[B+2]); X[B+3]=EX(X[B+3]); PIN(X); SBAR(); }while(0)
  #define VRD(i) do{ vlo[i]=vtr(vp_+(((i)>>2)*4096+((i)&3)*1024)); vhi[i]=vtr(vp_+(((i)>>2)*4096+((i)&3)*1024+512)); }while(0)
  #define KRD(G,j) do{ if(G){ kload2(kf,kp0+sl_next,j); SBAR(); } }while(0)
  #define STEP(C0,C1,P0,P1,t,GK,GV,GL) do{ SBAR(); FSUB(C0,C1); SBAR(); \
    const lds_cptr vp_=vp0+sl_prev; \
    VRD(0); SBAR(); float sacc=(P0[0]+P0[1]); \
    GAPA(C0=__builtin_amdgcn_mfma_f32_32x32x16_bf16(kf[0],qr[0],C0,0,0,0), P0[2],P0[3],P0[4],P0[5],     pw0[0]=PKW(P0,0), pw0[1]=PKW(P0,2), pw0); \
    VRD(4); SBAR(); GAPA(C1=__builtin_amdgcn_mfma_f32_32x32x16_bf16(kf[1],qr[0],C1,0,0,0), P0[6],P0[7],P0[8],P0[9],     pw0[2]=PKW(P0,4), pw0[3]=PKW(P0,6), pw0); \
    VRD(1); SBAR(); GAPA(C0=__builtin_amdgcn_mfma_f32_32x32x16_bf16(kf[2],qr[1],C0,0,0,0),   P0[10],P0[11],P0[12],P0[13], pw1[0]=PKW(P0,8), pw1[1]=PKW(P0,10), pw1); \
    VRD(5); SBAR(); GAPA(C1=__builtin_amdgcn_mfma_f32_32x32x16_bf16(kf[3],qr[1],C1,0,0,0),   P0[14],P0[15],P1[0],P1[1],   pw1[2]=PKW(P0,12),pw1[3]=PKW(P0,14), pw1); \
    VRD(2); SBAR(); GAPA(C0=__builtin_amdgcn_mfma_f32_32x32x16_bf16(kf[4],qr[2],C0,0,0,0),   P1[2],P1[3],P1[4],P1[5],     pw2[0]=PKW(P1,0), pw2[1]=PKW(P1,2), pw2); \
    VRD(6); SBAR(); GAPA(C1=__builtin_amdgcn_mfma_f32_32x32x16_bf16(kf[5],qr[2],C1,0,0,0),   P1[6],P1[7],P1[8],P1[9],     pw2[2]=PKW(P1,4), pw2[3]=PKW(P1,6), pw2); \
    VRD(3); SBAR(); GAPA(C0=__builtin_amdgcn_mfma_f32_32x32x16_bf16(kf[6],qr[3],C0,0,0,0),   P1[10],P1[11],P1[12],P1[13], pw3[0]=PKW(P1,8), pw3[1]=PKW(P1,10), pw3); \
    VRD(7); SBAR(); GAPA(C1=__builtin_amdgcn_mfma_f32_32x32x16_bf16(kf[7],qr[3],C1,0,0,0),   P1[14],P1[15],0.f,0.f,       pw3[2]=PKW(P1,12),pw3[3]=PKW(P1,14), pw3); \
    l_reg+=sacc; \
    if(GK){DMA_K((t)+3,sl_cur);} if(GV){DMA_V((t)+1,sl_next);} \
    CMASK(C0,C1,t); \
    { float a=MX3(C0[0],C0[1],C1[0]),b=MX3(C0[2],C0[3],C1[1]); a=MX3(a,C1[2],C1[3]); \
      _Pragma("unroll") for(int r=4;r<16;r+=4){a=MX3(a,C0[r],C0[r+1]);b=MX3(b,C0[r+2],C0[r+3]);a=MX3(a,C1[r],C1[r+1]);b=MX3(b,C1[r+2],C1[r+3]);} \
      float rm=__builtin_fmaxf(a,b); { auto rr=__builtin_amdgcn_permlane32_swap(__float_as_uint(rm),__float_as_uint(rm),false,false); rm=__builtin_fmaxf(__uint_as_float(rr[0]),__uint_as_float(rr[1])); } \
      resc=false; \
      if(__builtin_expect(__any(rm>(float)THRL),0)){ const float dl=__builtin_fmaxf(rm,0.f); fref-=dl; \
        _Pragma("unroll") for(int r=0;r<16;++r){C0[r]-=dl;C1[r]-=dl;} \
        const float f=__builtin_amdgcn_exp2f(-dl); l_reg*=f; { int l2_; asm volatile("v_mbcnt_lo_u32_b32 %0, -1, 0\n\tv_mbcnt_hi_u32_b32 %0, -1, %0":"=v"(l2_)); if(l2_<32)wsf[l2_]=f; } resc=true; } } \
    SBAR(); \
    GAPB(o[0]=__builtin_amdgcn_mfma_f32_32x32x16_bf16(PAF(0),VFR(0),o[0],0,0,0), C0,0); \
    GAPB(o[1]=__builtin_amdgcn_mfma_f32_32x32x16_bf16(PAF(0),VFR(4),o[1],0,0,0), C0,4); \
    KRD(GL,0); GAPB(o[0]=__builtin_amdgcn_mfma_f32_32x32x16_bf16(PAF(1),VFR(1),o[0],0,0,0), C0,8); \
    KRD(GL,1); GAPB(o[1]=__builtin_amdgcn_mfma_f32_32x32x16_bf16(PAF(1),VFR(5),o[1],0,0,0), C0,12); \
    KRD(GL,2); GAPB(o[0]=__builtin_amdgcn_mfma_f32_32x32x16_bf16(PAF(2),VFR(2),o[0],0,0,0), C1,0); \
    KRD(GL,3); GAPB(o[1]=__builtin_amdgcn_mfma_f32_32x32x16_bf16(PAF(2),VFR(6),o[1],0,0,0), C1,4); \
    GAPB(o[0]=__builtin_amdgcn_mfma_f32_32x32x16_bf16(PAF(3),VFR(3),o[0],0,0,0), C1,8); \
    GAPB(o[1]=__builtin_amdgcn_mfma_f32_32x32x16_bf16(PAF(3),VFR(7),o[1],0,0,0), C1,12); \
    if(GL){ FLOAD(P0,P1,(t)+1); } \
    }while(0)
  int t=1;
  #undef CMASK
  #define CMASK(P0,P1,t) do{}while(0)
  for(;t+5<NT;t+=2){
    STEP(pB0,pB1,pA0,pA1,t,true,true,true);     WAIT_BAR(2); RESC(); ROT();
    STEP(pA0,pA1,pB0,pB1,t+1,true,true,true);   WAIT_BAR(2); RESC(); ROT();
  }
  #undef CMASK
  #define CMASK(P0,P1,t) do{int jb_=(t)-(NT-4); if(jb_>=0)cmask(P0,P1,jb_,qrel,hi);}while(0)
  #define ENDW(tt) do{ if((tt)+3<NT){WAIT_BAR(2);} else if((tt)+2<NT){WAIT_BAR(1);} else {WAIT_BAR(0);} }while(0)
  for(;t+1<NT;t+=2){
    STEP(pB0,pB1,pA0,pA1,t,(t+3<NT),(t+1<NT),(t+1<NT));       ENDW(t);   RESC(); ROT();
    STEP(pA0,pA1,pB0,pB1,t+1,(t+4<NT),(t+2<NT),(t+2<NT));     ENDW(t+1); RESC(); ROT();
  }
  STEP(pB0,pB1,pA0,pA1,NT-1,false,false,false); RESC();
  { float sacc=pB0[0]+pB0[1]; _Pragma("unroll") for(int r=2;r<16;++r)sacc+=pB0[r]; _Pragma("unroll") for(int r=0;r<16;++r)sacc+=pB1[r]; l_reg+=sacc;
    pw0=(u32x4){PKW(pB0,0),PKW(pB0,2),PKW(pB0,4),PKW(pB0,6)};pw1=(u32x4){PKW(pB0,8),PKW(pB0,10),PKW(pB0,12),PKW(pB0,14)};pw2=(u32x4){PKW(pB1,0),PKW(pB1,2),PKW(pB1,4),PKW(pB1,6)};pw3=(u32x4){PKW(pB1,8),PKW(pB1,10),PKW(pB1,12),PKW(pB1,14)};
    SBAR(); pv(o,vb0+sl_cur,PAF(0),PAF(1),PAF(2),PAF(3)); }
  #undef PKW
  #undef PAF
  #undef VFR
  #undef PIN
  #undef MX3
  #undef GAPA
  #undef GAPB
  #undef EX
  #undef VRD
  #undef KRD
  #undef STEP
  #undef ENDW
  {auto rr=__builtin_amdgcn_permlane32_swap(__float_as_uint(l_reg),__float_as_uint(l_reg),false,false);l_reg=__uint_as_float(rr[0])+__uint_as_float(rr[1]);}
  if(hi==0)wsf[32+r32]=l_reg;asm volatile("s_waitcnt lgkmcnt(0)":::"memory");
  float rli[16];
  #pragma unroll
  for(int r=0;r<16;++r)rli[r]=__builtin_amdgcn_rcpf(wsf[32+crow(r,hi)]);
  bf16*Ow=O+(long)(q0+wid*QBLK)*PO+h*D; const bf16*Gw=G+(long)(q0+wid*QBLK)*DM+h*D;
  { bf16*stg=(bf16*)(shm+LDS_OST)+wid*2048;
    #pragma unroll
    for(int r=0;r<16;++r){const int orow=crow(r,hi);
      #pragma unroll
      for(int d0=0;d0<2;++d0)stg[orow*64+d0*32+r32]=__float2bfloat16(o[d0][r]*rli[r]);}
    asm volatile("s_waitcnt lgkmcnt(0)":::"memory");
    #pragma unroll
    for(int i=0;i<4;++i){const int row=i*8+(lane>>3),ch=lane&7; u32x4 v=*(const u32x4*)(stg+row*64+ch*8); const u32x4 g=*(const u32x4*)(Gw+(long)row*DM+ch*8);
      _Pragma("unroll") for(int e=0;e<4;++e){ const float gl=__uint_as_float(g[e]<<16), gh=__uint_as_float(g[e]&0xffff0000u), vl=__uint_as_float(v[e]<<16), vh=__uint_as_float(v[e]&0xffff0000u);
        const float sl=gl*__builtin_amdgcn_rcpf(1.f+__expf(-gl)), sh=gh*__builtin_amdgcn_rcpf(1.f+__expf(-gh)); v[e]=cvtpk_s(vl*sl,vh*sh); }
      ATTN_STORE16(Ow+(long)row*PO+ch*8,v);} }
  asm volatile("s_waitcnt lgkmcnt(0)\n\ts_barrier":::"memory");
  #undef DMA_K
  #undef DMA_V
  #undef CMASK
  #undef START
  #undef RESC
  #undef ROT
  #undef FLOAD
  #undef FSUB
}
constexpr int ATTN_LDS_BYTES=LDS_BYTES;
#undef SBAR
#undef WAIT_BAR
}
namespace cg = cooperative_groups;
constexpr int NWAVES = 8, NTHR = 512;
constexpr int T = 16384, DMODEL = 2048, INCOLS = 8336, NPAD = 8448, DPLE = 256, RW = 1024, FX = 1024, NH = 16, HD = 64;
constexpr int M = T;
constexpr float RMS_EPS = 1e-6f, GN_EPS = 64e-5f, LOG2E = 1.4426950408889634f;
constexpr size_t MiB = 1u << 20;
constexpr size_t WS_CTL = 0, WS_WIN = 1 * MiB, WS_WOUT = 34 * MiB, WS_WGATE = 42 * MiB, WS_WPLE = 50 * MiB, WS_W2T = 51 * MiB, WS_A2T = 51 * MiB + 512 * 1024, WS_PB = 52 * MiB,
                 WS_F2 = 60 * MiB, WS_RK = 61 * MiB, WS_SSQ = 62 * MiB, WS_XN = 64 * MiB, WS_ZS = 128 * MiB, WS_ZA = 144 * MiB, WS_ZB = 240 * MiB, WS_KP = 400 * MiB, WS_RS = 432 * MiB, WS_VS = 464 * MiB, WS_END = 500 * MiB;
constexpr size_t WS_YR = WS_ZA, WS_MB = WS_ZB, WS_PLE = WS_ZA + 32 * MiB;
constexpr size_t OUT_W1A = 0, OUT_QA = 32 * MiB, OUT_BT = 64 * MiB, OUT_KT = 96 * MiB;
constexpr size_t WS_U0 = WS_KP, WS_Y0 = WS_RS, WS_DD = 496 * MiB;
constexpr int LDS_BYTES = 154624;
constexpr int MISC_OFF = 153600;
constexpr int NRWB = 64;
#define LAS __attribute__((address_space(3)))
typedef unsigned short bf16;
typedef unsigned v4u __attribute__((ext_vector_type(4)));
typedef unsigned v2u __attribute__((ext_vector_type(2)));
typedef float f32x4 __attribute__((ext_vector_type(4)));
typedef short bf16x8 __attribute__((ext_vector_type(8)));
#define LDS_WAIT() asm volatile("s_waitcnt lgkmcnt(0)" ::: "memory")
#define RLX_AGENT __ATOMIC_RELAXED, __HIP_MEMORY_SCOPE_AGENT
#define LDS_WAIT() asm volatile("s_waitcnt lgkmcnt(0)" ::: "memory")
#define XB_TMO      128
#define XB_XCNT(j)  (256  + 64 * (j))
#define XB_XSUB(j)  (1280 + 64 * (j))
#define XB_XGEN(j)  (2304 + 64 * (j))
#define XB_TOP      3328
#define XB_TOPGEN   3392
#define XCD_BAR_WORDS 3456
#define XB_SPIN_CAP (1u << 22)

__device__ __forceinline__ unsigned xb_ld(unsigned* p)              { return __hip_atomic_load(p, __ATOMIC_RELAXED, __HIP_MEMORY_SCOPE_AGENT); }
__device__ __forceinline__ unsigned xb_add(unsigned* p, unsigned v) { return __hip_atomic_fetch_add(p, v, __ATOMIC_RELAXED, __HIP_MEMORY_SCOPE_AGENT); }
__device__ __forceinline__ unsigned xb_xcc_id() { return (unsigned)__builtin_amdgcn_s_getreg((3 << 11) | 20) & 0xFu; }
#define XB_SPIN(cond, bar) do { unsigned _sp = 0; while (cond) { __builtin_amdgcn_s_sleep(1); \
    if ((++_sp & 255u) == 0u) { if (xb_ld(&(bar)[XB_TMO])) break; if (_sp > XB_SPIN_CAP) { atomicAdd(&(bar)[XB_TMO], 1u); break; } } } } while (0)

struct XcdBarrier {
    unsigned* bar; unsigned x;
    volatile LAS unsigned* st;
};

__device__ __forceinline__ XcdBarrier xcd_barrier_post(unsigned* bar, volatile LAS unsigned* st, int tid) {
    XcdBarrier b; b.bar = bar; b.x = xb_xcc_id(); b.st = st;
    if (tid == 0) (void)xb_add(&bar[XB_XCNT(b.x)], 1u);
    return b;
}
__device__ __forceinline__ void xcd_barrier_complete(unsigned* bar, unsigned x, unsigned& nloc, unsigned& nx) {
    const unsigned G = gridDim.x * gridDim.y * gridDim.z;
    unsigned sum, cnt, mine, sp = 0u;
    for (;;) {
        sum = 0u; cnt = 0u; mine = 0u;
#pragma unroll
        for (unsigned j = 0; j < 16; ++j) { const unsigned c = xb_ld(&bar[XB_XCNT(j)]); sum += c; cnt += (c > 0u) ? 1u : 0u; mine = (j == x) ? c : mine; }
        if (sum == G) break;
        __builtin_amdgcn_s_sleep(1);
        if ((++sp & 255u) == 0u) { if (xb_ld(&bar[XB_TMO])) break; if (sp > XB_SPIN_CAP) { atomicAdd(&bar[XB_TMO], 1u); break; } }
    }
    nloc = mine > 0u ? mine : 1u; nx = cnt > 0u ? cnt : 1u;
}

__device__ __forceinline__ void xcd_barrier(const XcdBarrier& b, int tid) {
    asm volatile("s_waitcnt vmcnt(0)" ::: "memory");
    __syncthreads();
    if (tid == 0) {
        unsigned* bar = b.bar;
        __builtin_amdgcn_s_waitcnt(0);
        unsigned nloc = b.st[0], nx = b.st[1];
        if (nloc == 0u) { xcd_barrier_complete(bar, b.x, nloc, nx); b.st[0] = nloc; b.st[1] = nx; }
        const unsigned old = xb_add(&bar[XB_XSUB(b.x)], 1u);
        const unsigned gen = old / nloc;
        if (old + 1u == (gen + 1u) * nloc) {
            __builtin_amdgcn_fence(__ATOMIC_RELEASE, "agent");
            asm volatile("s_waitcnt vmcnt(0)" ::: "memory");
            const unsigned og = xb_add(&bar[XB_TOP], 1u);
            const unsigned tg = og / nx;
            if (og + 1u == (tg + 1u) * nx) xb_add(&bar[XB_TOPGEN], 1u);
            else XB_SPIN(xb_ld(&bar[XB_TOPGEN]) == tg, bar);
            __builtin_amdgcn_fence(__ATOMIC_ACQUIRE, "agent");
            xb_add(&bar[XB_XGEN(b.x)], 1u);
            asm volatile("s_waitcnt vmcnt(0)" ::: "memory");
        } else {
            XB_SPIN(xb_ld(&bar[XB_XGEN(b.x)]) == gen, bar);
            __builtin_amdgcn_fence(__ATOMIC_ACQUIRE, "agent");
            asm volatile("s_waitcnt vmcnt(0)" ::: "memory");
        }
    }
    __syncthreads();
}
__device__ __forceinline__ unsigned f2bf(float f) { unsigned u = __builtin_bit_cast(unsigned, f); return (u + 0x7fffu + ((u >> 16) & 1u)) >> 16; }
typedef float f32x2_ __attribute__((ext_vector_type(2))); typedef __bf16 bf16x2_ __attribute__((ext_vector_type(2)));
__device__ __forceinline__ unsigned pk2(float lo, float hi) { f32x2_ v = {lo, hi}; return __builtin_bit_cast(unsigned, __builtin_convertvector(v, bf16x2_)); }
__device__ __forceinline__ float bflo(unsigned u) { return __uint_as_float(u << 16); }
__device__ __forceinline__ float bfhi(unsigned u) { return __uint_as_float(u & 0xffff0000u); }
__device__ __forceinline__ float wave_sum(float v) {
#pragma unroll
    for (int o = 1; o < 64; o <<= 1) v += __shfl_xor(v, o);
    return v;
}
__device__ __forceinline__ float dpp_add(float x, float y_src, int) { return x + y_src; }
__device__ __forceinline__ float row16_sum(float x) {
    x += __uint_as_float(__builtin_amdgcn_update_dpp(0, __float_as_uint(x), 0xB1, 0xf, 0xf, false));
    x += __uint_as_float(__builtin_amdgcn_update_dpp(0, __float_as_uint(x), 0x4E, 0xf, 0xf, false));
    x += __uint_as_float(__builtin_amdgcn_update_dpp(0, __float_as_uint(x), 0x141, 0xf, 0xf, false));
    x += __uint_as_float(__builtin_amdgcn_update_dpp(0, __float_as_uint(x), 0x140, 0xf, 0xf, false));
    return x;
}
__device__ __forceinline__ float quad_sum(float x) {
    x += __uint_as_float(__builtin_amdgcn_update_dpp(0, __float_as_uint(x), 0xB1, 0xf, 0xf, false));
    x += __uint_as_float(__builtin_amdgcn_update_dpp(0, __float_as_uint(x), 0x4E, 0xf, 0xf, false));
    return x;
}
struct Args { const float* in[26]; float* out; unsigned char* ws; };
__device__ __forceinline__ int lane_id() { int l__; asm volatile("v_mbcnt_lo_u32_b32 %0, -1, 0\n\tv_mbcnt_hi_u32_b32 %0, -1, %0" : "=v"(l__)); return l__; }
struct Frame {
    LAS unsigned char* lds; int wave, G, gw, NGW, lane, tid;
};
#define PHASE_BEGIN() do { int l_ = lane_id(); asm volatile("" : "+v"(l_)); F.lane = l_; F.tid = F.wave * 64 + l_; } while (0)

__device__ __forceinline__ void p0_transpose_item(const float* W, int K, int N, bf16* WT, int k0, int n0, int dst_row0, LAS float* scr, int lane) {
    const bool ok = (n0 + (lane & 31)) < N;
    float tv[32];
#pragma unroll
    for (int i = 0; i < 32; ++i) { const int kk = 2 * i + (lane >> 5); tv[i] = ok ? W[(size_t)(k0 + kk) * N + n0 + (lane & 31)] : 0.f; }
#pragma unroll
    for (int i = 0; i < 32; ++i) { const int kk = 2 * i + (lane >> 5); scr[kk * 33 + (lane & 31)] = tv[i]; }
    LDS_WAIT(); asm volatile("" ::: "memory");
    const int c = lane & 7;
#pragma unroll
    for (int j = 0; j < 4; ++j) { const int n = (lane >> 3) + 8 * j; const LAS float* s = scr + (8 * c) * 33 + n;
        v4u o; o.x = pk2(s[0 * 33], s[1 * 33]); o.y = pk2(s[2 * 33], s[3 * 33]); o.z = pk2(s[4 * 33], s[5 * 33]); o.w = pk2(s[6 * 33], s[7 * 33]);
        *(v4u*)(WT + (size_t)(dst_row0 + n) * K + k0 + 8 * c) = o; }
    LDS_WAIT(); asm volatile("" ::: "memory");
}
__device__ __forceinline__ int win_map(int c) {
    if (c < 3072) return c;
    if (c < 4096) return c - 3072 + 7168;
    if (c < 4160) return c - 4096 + 8192;
    if (c < 4224) return c - 4160 + 8256;
    if (c < 8320) return c - 4224 + 3072;
    return c - 8320 + 8320;
}
__device__ __forceinline__ void rms_row_to_bf16(const float* xrow, const float* g, bf16* orow, int lane) {
    const f32x4* xr = (const f32x4*)xrow + lane; const f32x4* gr = (const f32x4*)g + lane;
    f32x4 v[8]; float s = 0.f;
#pragma unroll
    for (int j = 0; j < 8; ++j) { v[j] = xr[64 * j]; s += (v[j].x * v[j].x + v[j].y * v[j].y) + (v[j].z * v[j].z + v[j].w * v[j].w); }
    const float rstd = 1.f / sqrtf(wave_sum(s) * (1.f / DMODEL) + RMS_EPS);
    v2u* o8 = (v2u*)orow + lane;
#pragma unroll
    for (int j = 0; j < 8; ++j) { const f32x4 gg = gr[64 * j]; v2u o; o.x = pk2(v[j].x * rstd * gg.x, v[j].y * rstd * gg.y); o.y = pk2(v[j].z * rstd * gg.z, v[j].w * rstd * gg.w); o8[64 * j] = o; }
}

__device__ __forceinline__ void rms_row2_to_bf16(const float* x0, const float* x1, const float* g, bf16* o0, bf16* o1, int lane) {
    const f32x4* xr0 = (const f32x4*)x0 + lane; const f32x4* xr1 = (const f32x4*)x1 + lane; const f32x4* gr = (const f32x4*)g + lane;
    f32x4 v[8], w[8]; float s = 0.f, t = 0.f;
#pragma unroll
    for (int j = 0; j < 8; ++j) { v[j] = xr0[64 * j]; w[j] = xr1[64 * j]; }
#pragma unroll
    for (int j = 0; j < 8; ++j) { s += (v[j].x * v[j].x + v[j].y * v[j].y) + (v[j].z * v[j].z + v[j].w * v[j].w); t += (w[j].x * w[j].x + w[j].y * w[j].y) + (w[j].z * w[j].z + w[j].w * w[j].w); }
#pragma unroll
    for (int o = 1; o < 64; o <<= 1) { s += __shfl_xor(s, o); t += __shfl_xor(t, o); }
    const float r0 = 1.f / sqrtf(s * (1.f / DMODEL) + RMS_EPS), r1 = 1.f / sqrtf(t * (1.f / DMODEL) + RMS_EPS);
    v2u* p0 = (v2u*)o0 + lane; v2u* p1 = (v2u*)o1 + lane;
#pragma unroll
    for (int j = 0; j < 8; ++j) { const f32x4 gg = gr[64 * j]; const f32x4 a0 = v[j] * r0 * gg, a1 = w[j] * r1 * gg; v2u q0, q1; q0.x = pk2(a0.x, a0.y); q0.y = pk2(a0.z, a0.w); q1.x = pk2(a1.x, a1.y); q1.y = pk2(a1.z, a1.w); p0[64 * j] = q0; p1[64 * j] = q1; }
}
__device__ __forceinline__ void p0_prologue(Frame& F, const Args& a) {
    unsigned char* ws = a.ws;
    LAS float* scr = (LAS float*)(F.lds + F.wave * 16384);
    bf16* Wt_in = (bf16*)(ws + WS_WIN); bf16* Wt_out = (bf16*)(ws + WS_WOUT); bf16* Wt_gate = (bf16*)(ws + WS_WGATE); bf16* Wt_ple = (bf16*)(ws + WS_WPLE); bf16* W2t = (bf16*)(ws + WS_W2T); bf16* A2t = (bf16*)(ws + WS_A2T);
    constexpr int NB_IN = (INCOLS + 31) / 32;
    constexpr int I_IN = (DMODEL / 64) * NB_IN, I_SQ = (DMODEL / 64) * (DMODEL / 32), I_PLE = (DPLE / 64) * (DMODEL / 32), I_LORA = (64 / 64) * (RW / 32);
    constexpr int NITEMS = I_IN + 2 * I_SQ + I_PLE + 2 * I_LORA;
    for (int it = F.gw; it < NITEMS; it += F.NGW) {
        int r = it;
        if (r < I_IN) { const int kb = r / NB_IN, nb = r % NB_IN; p0_transpose_item(a.in[3], DMODEL, INCOLS, Wt_in, 64 * kb, 32 * nb, win_map(32 * nb), scr, F.lane); continue; } r -= I_IN;
        if (r < I_SQ) { const int kb = r / 64, nb = r % 64; p0_transpose_item(a.in[21], DMODEL, DMODEL, Wt_out, 64 * kb, 32 * nb, 32 * nb, scr, F.lane); continue; } r -= I_SQ;
        if (r < I_SQ) { const int kb = r / 64, nb = r % 64; p0_transpose_item(a.in[24], DMODEL, DMODEL, Wt_gate, 64 * kb, 32 * nb, 32 * nb, scr, F.lane); continue; } r -= I_SQ;
        if (r < I_PLE) { const int kb = r / 64, nb = r % 64; p0_transpose_item(a.in[25], DPLE, DMODEL, Wt_ple, 64 * kb, 32 * nb, 32 * nb, scr, F.lane); continue; } r -= I_PLE;
        if (r < I_LORA) { p0_transpose_item(a.in[10], 64, RW, W2t, 0, 32 * r, 32 * r, scr, F.lane); continue; } r -= I_LORA;
        p0_transpose_item(a.in[12], 64, RW, A2t, 0, 32 * r, 32 * r, scr, F.lane);
    }
    { v4u* z = (v4u*)(Wt_in + (size_t)8352 * DMODEL); const int n16 = (NPAD - 8352) * DMODEL * 2 / 16; const v4u zero = {0u, 0u, 0u, 0u};
      for (int i = F.gw * 64 + F.lane; i < n16; i += F.NGW * 64) z[i] = zero; }
    bf16* XN = (bf16*)(ws + WS_XN);
    for (int m = F.gw; m < M; m += 2 * F.NGW) rms_row2_to_bf16(a.in[0] + (size_t)m * DMODEL, a.in[0] + (size_t)(m + F.NGW) * DMODEL, a.in[2], XN + (size_t)m * DMODEL, XN + (size_t)(m + F.NGW) * DMODEL, F.lane);
    { const f32x4* p4 = (const f32x4*)a.in[1]; v4u* o = (v4u*)(ws + WS_PB); const int n8 = M * DPLE / 8;
      for (int i = F.gw * 64 + F.lane; i < n8; i += F.NGW * 64) { const f32x4 u0 = p4[2 * i], u1 = p4[2 * i + 1]; v4u w; w.x = pk2(u0.x, u0.y); w.y = pk2(u0.z, u0.w); w.z = pk2(u1.x, u1.y); w.w = pk2(u1.z, u1.w); o[i] = w; } }
}

__device__ __forceinline__ float log_sigmoid(float x) { return fminf(x, 0.f) - log1pf(expf(-fabsf(x))); }
__device__ __forceinline__ void p2a_fgroup(Frame& F, const Args& a, int g) {
    const float* ZS = (const float*)(a.ws + WS_ZS); float* F2 = (float*)(a.ws + WS_F2); float* PS = (float*)(a.ws + WS_SSQ);
    LAS float* sc = (LAS float*)F.lds;
    const int h = F.tid & 15, r0 = F.tid >> 4; const float bf = a.in[18][h];
#pragma unroll
    for (int k = 0; k < 2; ++k) { const int r = r0 + 32 * k; sc[r * 16 + h] = log_sigmoid(ZS[(size_t)(g * 64 + r) * 256 + 128 + h] + bf) * LOG2E; }
    __syncthreads();
    if (F.tid < 16) { float run = 0.f; for (int r = 0; r < 64; ++r) { run += sc[r * 16 + F.tid]; sc[r * 16 + F.tid] = run; } PS[g * 16 + F.tid] = run; }
    __syncthreads();
#pragma unroll
    for (int k = 0; k < 2; ++k) { const int r = r0 + 32 * k; F2[(size_t)h * T + g * 64 + r] = sc[r * 16 + h]; }
    __syncthreads();
}
__device__ __forceinline__ void p2b_fgroup(Frame& F, const Args& a, int g) {
    float* F2 = (float*)(a.ws + WS_F2); const float* PS = (const float*)(a.ws + WS_SSQ);
    LAS float* sc = (LAS float*)F.lds;
    const int h = F.tid & 15, part = F.tid >> 4; float s = 0.f;
    for (int gg = part; gg < g; gg += 32) s += PS[gg * 16 + h];
    sc[part * 16 + h] = s; __syncthreads();
    if (F.tid < 16) { float o = 0.f; for (int p = 0; p < 32; ++p) o += sc[p * 16 + F.tid]; sc[512 + F.tid] = o; }
    __syncthreads();
    const float off = sc[512 + h];
#pragma unroll
    for (int k = 0; k < 2; ++k) { const int r = part + 32 * k; F2[(size_t)h * T + g * 64 + r] += off; }
    __syncthreads();
}
__device__ __forceinline__ void p2_qknorm_row(const Args& a, int row, int lane) {
    bf16* zb = (bf16*)(a.ws + WS_ZB) + (size_t)row * 5120;
#pragma unroll
    for (int part = 0; part < 2; ++part) {
        v4u* p = (v4u*)(zb + part * 1024 + lane * 16); const v4u u0 = p[0], u1 = p[1];
        float x[16];
#pragma unroll
        for (int e = 0; e < 4; ++e) { x[2 * e] = bflo(u0[e]); x[2 * e + 1] = bfhi(u0[e]); x[8 + 2 * e] = bflo(u1[e]); x[8 + 2 * e + 1] = bfhi(u1[e]); }
        float ss = 0.f;
#pragma unroll
        for (int e = 0; e < 16; ++e) ss += x[e] * x[e];
        ss = quad_sum(ss);
        const float rstd = (1.f / sqrtf(ss * (1.f / 64.f) + RMS_EPS)) * (part == 0 ? attn_body::C2 : 1.f);
        const f32x4* g4 = (const f32x4*)(a.in[part == 0 ? 19 : 20] + (lane & 3) * 16);
        v4u o0, o1;
#pragma unroll
        for (int e = 0; e < 2; ++e) { const f32x4 ga = g4[e], gb = g4[2 + e];
            o0[2 * e] = pk2(x[4 * e] * rstd * ga.x, x[4 * e + 1] * rstd * ga.y); o0[2 * e + 1] = pk2(x[4 * e + 2] * rstd * ga.z, x[4 * e + 3] * rstd * ga.w);
            o1[2 * e] = pk2(x[8 + 4 * e] * rstd * gb.x, x[8 + 4 * e + 1] * rstd * gb.y); o1[2 * e + 1] = pk2(x[8 + 4 * e + 2] * rstd * gb.z, x[8 + 4 * e + 3] * rstd * gb.w); }
        p[0] = o0; p[1] = o1;
    }
}
__device__ __forceinline__ f32x4 ld4(const float* p) { return *(const f32x4*)p; }
__device__ __forceinline__ f32x4 bf4(v2u u) { return (f32x4){bflo(u.x), bfhi(u.x), bflo(u.y), bfhi(u.y)}; }
__device__ __forceinline__ v2u pk4(f32x4 v) { v2u o; o.x = pk2(v.x, v.y); o.y = pk2(v.z, v.w); return o; }
__device__ __forceinline__ float fast_tanh(float x) { x = fminf(fmaxf(x, -15.f), 15.f); const float e = __expf(2.f * x); return (e - 1.f) / (e + 1.f); }
typedef short bf16x4s __attribute__((ext_vector_type(4)));
__device__ __forceinline__ bf16x4s pk4s(f32x4 v) { return __builtin_bit_cast(bf16x4s, pk4(v)); }
__device__ __forceinline__ bf16x8 pk8s(f32x4 a, f32x4 b) { v4u u; u.x = pk2(a.x, a.y); u.y = pk2(a.z, a.w); u.z = pk2(b.x, b.y); u.w = pk2(b.z, b.w); return __builtin_bit_cast(bf16x8, u); }
#define MFMA16(a, b, c) __builtin_amdgcn_mfma_f32_16x16x16bf16_1k(a, b, c, 0, 0, 0)
#define MFMA32(a, b, c) __builtin_amdgcn_mfma_f32_16x16x32_bf16(a, b, c, 0, 0, 0)
__device__ __forceinline__ f32x4 exp4(f32x4 x) { return (f32x4){__expf(x.x), __expf(x.y), __expf(x.z), __expf(x.w)}; }
__device__ __forceinline__ f32x4 shfl4(f32x4 v, int src) { return (f32x4){__shfl(v.x, src), __shfl(v.y, src), __shfl(v.z, src), __shfl(v.w, src)}; }
__device__ __forceinline__ void rw_chunk_prep(const Args& a, int head, int tc0, const LAS bf16* TDr, const LAS bf16* DAr, LAS unsigned char* lw_, int lane) {
    unsigned char* ws = a.ws;
    const bf16* ZA = (const bf16*)(ws + WS_ZA);
    const int j = lane & 15, rg = lane >> 4, kg = rg, cbase = head * 64 + 4 * j;
    const bf16* W2t = (const bf16*)(ws + WS_W2T); const bf16* A2t = (const bf16*)(ws + WS_A2T);
    f32x4 accw[4], acca[4];
    {   bf16x8 atd[2], ada[2];
#pragma unroll
        for (int kk = 0; kk < 2; ++kk) { atd[kk] = *(const LAS bf16x8*)(TDr + j * 64 + kk * 32 + kg * 8); ada[kk] = *(const LAS bf16x8*)(DAr + j * 64 + kk * 32 + kg * 8); }
#pragma unroll
        for (int cb = 0; cb < 4; ++cb) { accw[cb] = (f32x4){0.f, 0.f, 0.f, 0.f}; acca[cb] = (f32x4){0.f, 0.f, 0.f, 0.f};
#pragma unroll
            for (int kk = 0; kk < 2; ++kk) { const bf16x8 bw = *(const bf16x8*)(W2t + (size_t)(cbase + cb) * 64 + kk * 32 + kg * 8), ba = *(const bf16x8*)(A2t + (size_t)(cbase + cb) * 64 + kk * 32 + kg * 8);
                accw[cb] = MFMA32(atd[kk], bw, accw[cb]); acca[cb] = MFMA32(ada[kk], ba, acca[cb]); } }
    }
    const f32x4 w0 = ld4(a.in[9] + cbase), a0 = ld4(a.in[11] + cbase), kkw = ld4(a.in[13] + cbase), kaw = ld4(a.in[14] + cbase), rkw = ld4(a.in[15] + cbase);
    const f32x4 mur = ld4(a.in[4] + cbase), muk = ld4(a.in[5] + cbase), muv = ld4(a.in[6] + cbase);
    float* RK = (float*)(ws + WS_RK);
    f32x4 rr[4], km[4], av[4], bv[4], lw[4], vv[4];
    {   const int tt0 = tc0 + 4 * rg; const f32x4 zero = {0.f, 0.f, 0.f, 0.f};
        f32x4 pr = tt0 > 0 ? bf4(*(const v2u*)(ZA + (size_t)(tt0 - 1) * 3072 + cbase)) : zero;
        f32x4 pk = tt0 > 0 ? bf4(*(const v2u*)(ZA + (size_t)(tt0 - 1) * 3072 + 1024 + cbase)) : zero;
        f32x4 pv = tt0 > 0 ? bf4(*(const v2u*)(ZA + (size_t)(tt0 - 1) * 3072 + 2048 + cbase)) : zero;
#pragma unroll
        for (int i = 0; i < 4; ++i) {
            const int tt = tt0 + i;
            const f32x4 zr = bf4(*(const v2u*)(ZA + (size_t)tt * 3072 + cbase)), zk = bf4(*(const v2u*)(ZA + (size_t)tt * 3072 + 1024 + cbase)), zv = bf4(*(const v2u*)(ZA + (size_t)tt * 3072 + 2048 + cbase));
            const f32x4 r = zr + (pr - zr) * mur, k = zk + (pk - zk) * muk, v = zv + (pv - zv) * muv;
            pr = zr; pk = zk; pv = zv;
            f32x4 lwv, alr;
#pragma unroll
            for (int cb = 0; cb < 4; ++cb) { const float x = -(w0[cb] + accw[cb][i]); const float sp = fmaxf(x, 0.f) + __logf(1.f + __expf(-fabsf(x))); lwv[cb] = -__expf(-sp - 0.5f); alr[cb] = __builtin_amdgcn_rcpf(1.f + __expf(-(a0[cb] + acca[cb][i]))); }
            const f32x4 kkr = k * kkw, kmod = k * (1.f + (alr - 1.f) * kaw);
            float ssq = (kkr.x * kkr.x + kkr.y * kkr.y) + (kkr.z * kkr.z + kkr.w * kkr.w);
            const f32x4 rkk = r * kmod * rkw; float rkp = (rkk.x + rkk.y) + (rkk.z + rkk.w);
            ssq = row16_sum(ssq); rkp = row16_sum(rkp);
            const float inv = __builtin_amdgcn_rsqf(fmaxf(ssq, 1e-24f));
            const f32x4 kk = kkr * inv;
            rr[i] = r; km[i] = kmod; av[i] = -kk; bv[i] = kk * alr; lw[i] = lwv; vv[i] = v;
            if (j == 0) RK[(size_t)tt * 16 + head] = rkp;
        }
    }
    f32x4 lci[4], ltot;
    {   lci[0] = lw[0]; lci[1] = lci[0] + lw[1]; lci[2] = lci[1] + lw[2]; lci[3] = lci[2] + lw[3];
        f32x4 s = lci[3];
        const f32x4 t1 = shfl4(s, lane - 16); if (rg >= 1) s = s + t1;
        const f32x4 t2 = shfl4(s, lane - 32); if (rg >= 2) s = s + t2;
        const f32x4 excl = s - lci[3];
        ltot = shfl4(s, 48 + j);
#pragma unroll
        for (int i = 0; i < 4; ++i) lci[i] = lci[i] + excl;
    }
    LAS bf16* TA = (LAS bf16*)lw_; LAS bf16* TR = TA + 1024; LAS bf16* TB = TR + 1024; LAS bf16* TK = TB + 1024; LAS float* MA = (LAS float*)(lw_ + 8192); LAS float* MT = MA + 256;
    f32x4 atT[4], rtT[4], bhT[4], khT[4], vT[4];
    {   f32x4 at[4], rt[4], bh[4], kh[4];
#pragma unroll
        for (int i = 0; i < 4; ++i) { const f32x4 ei = exp4(lci[i]), eo = exp4(-lci[i]), ee = exp4(lci[i] - lw[i]), eh = exp4(ltot - lci[i]);
            at[i] = av[i] * ee; rt[i] = rr[i] * ei; bh[i] = bv[i] * eh; kh[i] = km[i] * eh;
            const int row = 4 * rg + i;
            *(LAS v2u*)(TA + row * 64 + 4 * j) = pk4(at[i]); *(LAS v2u*)(TR + row * 64 + 4 * j) = pk4(rt[i]); *(LAS v2u*)(TB + row * 64 + 4 * j) = pk4(bv[i] * eo); *(LAS v2u*)(TK + row * 64 + 4 * j) = pk4(km[i] * eo); }
#pragma unroll
        for (int cb = 0; cb < 4; ++cb) { atT[cb] = (f32x4){at[0][cb], at[1][cb], at[2][cb], at[3][cb]}; rtT[cb] = (f32x4){rt[0][cb], rt[1][cb], rt[2][cb], rt[3][cb]};
            bhT[cb] = (f32x4){bh[0][cb], bh[1][cb], bh[2][cb], bh[3][cb]}; khT[cb] = (f32x4){kh[0][cb], kh[1][cb], kh[2][cb], kh[3][cb]}; vT[cb] = (f32x4){vv[0][cb], vv[1][cb], vv[2][cb], vv[3][cb]}; }
    }
    LDS_WAIT(); asm volatile("" ::: "memory");
    f32x4 AabT = {0.f, 0.f, 0.f, 0.f}, AakT = AabT, ArbT = AabT, ArkT = AabT;
#pragma unroll
    for (int kk = 0; kk < 2; ++kk) { const int o = j * 64 + kk * 32 + kg * 8;
        const bf16x8 pa = *(const LAS bf16x8*)(TA + o), pr = *(const LAS bf16x8*)(TR + o), pb = *(const LAS bf16x8*)(TB + o), pk = *(const LAS bf16x8*)(TK + o);
        AabT = MFMA32(pb, pa, AabT); AakT = MFMA32(pk, pa, AakT); ArbT = MFMA32(pb, pr, ArbT); ArkT = MFMA32(pk, pr, ArkT); }
#pragma unroll
    for (int e = 0; e < 4; ++e) { const int jp = 4 * rg + e; if (!(jp < j)) { AabT[e] = 0.f; AakT[e] = 0.f; } if (!(jp <= j)) { ArbT[e] = 0.f; ArkT[e] = 0.f; } }
    *(LAS f32x4*)(MA + j * 16 + 4 * rg) = AabT;
    LDS_WAIT(); asm volatile("" ::: "memory");
    {   float x[16];
#pragma unroll
        for (int t = 0; t < 16; ++t) { float s = (t == j) ? 1.f : 0.f;
#pragma unroll
            for (int q = 0; q < 4; ++q) { if (4 * q < t) { const f32x4 row = *(const LAS f32x4*)(MA + t * 16 + 4 * q);
#pragma unroll
                for (int e = 0; e < 4; ++e) if (4 * q + e < t) s += row[e] * x[4 * q + e]; } }
            x[t] = s; }
        if (rg == 0) {
#pragma unroll
            for (int t = 0; t < 16; ++t) MT[t * 16 + j] = x[t]; }
    }
    LDS_WAIT(); asm volatile("" ::: "memory");
    const bf16x4s TmA = pk4s(*(const LAS f32x4*)(MT + j * 16 + 4 * kg));
    const f32x4 z4 = {0.f, 0.f, 0.f, 0.f};
    const bf16x4s aak = pk4s(AakT), arb = pk4s(ArbT), ark = pk4s(ArkT);
    bf16x4s idb; { v2u u; u.x = ((4 * kg + 0 == j) ? 0x3F80u : 0u) | ((4 * kg + 1 == j) ? 0x3F800000u : 0u); u.y = ((4 * kg + 2 == j) ? 0x3F80u : 0u) | ((4 * kg + 3 == j) ? 0x3F800000u : 0u); idb = __builtin_bit_cast(bf16x4s, u); }
    const size_t ch = (size_t)(tc0 >> 4) * 16 + head;
    unsigned char* outb = (unsigned char*)a.out;
    f32x4 W1T[4], QT[4];
#pragma unroll
    for (int cb = 0; cb < 4; ++cb) {
        const bf16x4s atp = pk4s(atT[cb]), vtp = pk4s(vT[cb]);
        const f32x4 W1 = MFMA16(TmA, atp, z4);
        W1T[cb] = MFMA16(atp, TmA, z4);
        const f32x4 X = MFMA16(aak, vtp, z4);
        const f32x4 U0 = MFMA16(TmA, pk4s(X), z4);
        f32x4 q = MFMA16(pk4s(rtT[cb]), idb, z4);
        QT[cb] = MFMA16(pk4s(W1), arb, q);
        f32x4 y0 = MFMA16(arb, pk4s(U0), z4); y0 = MFMA16(ark, vtp, y0);
        *(v2u*)(ws + WS_U0 + ch * 2048 + cb * 512 + lane * 8) = pk4(U0);
        *(v2u*)(ws + WS_Y0 + ch * 2048 + cb * 512 + lane * 8) = pk4(y0);
        *(v2u*)(outb + OUT_BT + ch * 2048 + cb * 512 + lane * 8) = pk4(bhT[cb]);
        *(v2u*)(outb + OUT_KT + ch * 2048 + cb * 512 + lane * 8) = pk4(khT[cb]);
        *(v2u*)(ws + WS_VS + ch * 2048 + cb * 512 + lane * 8) = pk4(vT[cb]);
    }
#pragma unroll
    for (int kk = 0; kk < 2; ++kk) { *(bf16x8*)(outb + OUT_W1A + ch * 2048 + kk * 1024 + lane * 16) = pk8s(W1T[2 * kk], W1T[2 * kk + 1]); *(bf16x8*)(outb + OUT_QA + ch * 2048 + kk * 1024 + lane * 16) = pk8s(QT[2 * kk], QT[2 * kk + 1]); }
    if (rg == 0) { float* dd = (float*)(ws + WS_DD) + ch * 64; const f32x4 dv = exp4(ltot);
#pragma unroll
        for (int cb = 0; cb < 4; ++cb) dd[((j >> 2) * 4 + cb) * 4 + (j & 3)] = dv[cb]; }
    LDS_WAIT(); asm volatile("" ::: "memory");
}
__device__ __forceinline__ void p2_rwprep_tile(Frame& F, const Args& a, int t0) {
    unsigned char* ws = a.ws;
    const float* ZS = (const float*)(ws + WS_ZS);
    LAS bf16* TD = (LAS bf16*)F.lds; LAS bf16* DA = TD + 32 * 64;
    {
        const int tok = F.tid >> 4, c4 = (F.tid & 15) * 4, t = t0 + tok;
        const f32x4 zero = {0.f, 0.f, 0.f, 0.f};
        const f32x4 cw = ld4(ZS + (size_t)t * 256 + c4), ca = ld4(ZS + (size_t)t * 256 + 64 + c4);
        const f32x4 pw = t > 0 ? ld4(ZS + (size_t)(t - 1) * 256 + c4) : zero, pa = t > 0 ? ld4(ZS + (size_t)(t - 1) * 256 + 64 + c4) : zero;
        const f32x4 mw = ld4(a.in[7] + c4), ma = ld4(a.in[8] + c4);
        f32x4 dw = cw + (pw - cw) * mw, da = ca + (pa - ca) * ma;
        dw.x = fast_tanh(dw.x); dw.y = fast_tanh(dw.y); dw.z = fast_tanh(dw.z); dw.w = fast_tanh(dw.w);
        *(LAS v2u*)(TD + tok * 64 + c4) = pk4(dw); *(LAS v2u*)(DA + tok * 64 + c4) = pk4(da);
    }
    __syncthreads();
    LAS unsigned char* lw_ = F.lds + 8192 + F.wave * 10240;
    for (int q = 0; q < 4; ++q) { const int hh = q >> 1, rb = q & 1; rw_chunk_prep(a, 2 * F.wave + hh, t0 + rb * 16, TD + rb * 16 * 64, DA + rb * 16 * 64, lw_, F.lane); }
    __syncthreads();
}

struct ChunkOps { bf16x8 w1[2], qa[2]; bf16x4s bt[4], kt[4]; v2u u0, y0, vb; f32x4 d[4]; };
constexpr int SP_R = 15, SP_D = 14, SP_SLOT = 10240;
__device__ __forceinline__ void rw_slot_read(ChunkOps& C, const LAS unsigned char* s, int ib, int lane) {
    const int rg = lane >> 4;
#pragma unroll
    for (int kk = 0; kk < 2; ++kk) { C.w1[kk] = *(const LAS bf16x8*)(s + kk * 1024 + lane * 16); C.qa[kk] = *(const LAS bf16x8*)(s + 2048 + kk * 1024 + lane * 16); }
#pragma unroll
    for (int t = 0; t < 4; ++t) { C.bt[t] = *(const LAS bf16x4s*)(s + 4096 + t * 512 + lane * 8); C.kt[t] = *(const LAS bf16x4s*)(s + 6144 + t * 512 + lane * 8); C.d[t] = *(const LAS f32x4*)(s + 9728 + (rg * 4 + t) * 16); }
    C.u0 = *(const LAS v2u*)(s + 8192 + lane * 8); C.y0 = *(const LAS v2u*)(s + 8704 + lane * 8);
    C.vb = *(const LAS v2u*)(s + 9216 + lane * 8);
}
struct DmaPtrs { const unsigned char* p[4]; unsigned off[4]; };
__device__ __forceinline__ void rw_dma_init(const Args& a, DmaPtrs& P, int head, int ib, int lw, int lane) {
    const unsigned char* outb = (const unsigned char*)a.out; const unsigned char* ws = a.ws; const size_t c0 = (size_t)head * 2048;
    if (lw == 0) { P.p[0] = outb + OUT_W1A + c0 + lane * 16; P.p[1] = P.p[0] + 1024; P.p[2] = outb + OUT_QA + c0 + lane * 16; P.p[3] = P.p[2] + 1024; P.off[0] = 0u; P.off[1] = 1024u; P.off[2] = 2048u; P.off[3] = 3072u; }
    else if (lw == 1) { P.p[0] = outb + OUT_BT + c0 + lane * 16; P.p[1] = P.p[0] + 1024; P.p[2] = outb + OUT_KT + c0 + lane * 16; P.p[3] = P.p[2] + 1024; P.off[0] = 4096u; P.off[1] = 5120u; P.off[2] = 6144u; P.off[3] = 7168u; }
    else { const int l32 = lane & 31; P.p[0] = ws + WS_U0 + c0 + ib * 512 + l32 * 16; P.p[1] = ws + WS_Y0 + c0 + ib * 512 + l32 * 16; P.p[2] = ws + WS_VS + c0 + ib * 512 + l32 * 16; P.p[3] = ws + WS_DD + (size_t)head * 256 + (lane & 15) * 16;
           P.off[0] = 8192u; P.off[1] = 8704u; P.off[2] = 9216u; P.off[3] = 9728u; }
}
__device__ __forceinline__ void rw_dma_issue(DmaPtrs& P, int lw, int lane, unsigned slot_lds) {
    if (lw < 2) {
#pragma unroll
        for (int q = 0; q < 4; ++q) attn_body::glds16(P.p[q], (unsigned)__builtin_amdgcn_readfirstlane(slot_lds + P.off[q]));
    } else {
        if (lane < 32) {
#pragma unroll
            for (int q = 0; q < 3; ++q) attn_body::glds16(P.p[q], (unsigned)__builtin_amdgcn_readfirstlane(slot_lds + P.off[q])); }
        if (lane < 16) attn_body::glds16(P.p[3], (unsigned)__builtin_amdgcn_readfirstlane(slot_lds + P.off[3]));
    }
#pragma unroll
    for (int q = 0; q < 4; ++q) P.p[q] += (lw == 2 && q == 3) ? 16 * 256 : 16 * 2048;
}
__device__ __forceinline__ void p3_rwkv_state(Frame& F, const Args& a) {
    constexpr int NC = T / 16;
    const int xcd_ = blockIdx.x & 7, sl_ = blockIdx.x >> 3, head = 2 * xcd_ + (sl_ >> 2), ib = sl_ & 3, lane = F.lane, rg = lane >> 4;
    const unsigned lds0 = (unsigned)(uintptr_t)F.lds;
    const bool loader = F.wave >= 1 && F.wave <= 3; const int lw = F.wave - 1;
#define SP_BAR() asm volatile("s_waitcnt lgkmcnt(0)\n\ts_barrier" ::: "memory")
#define SP_WAIT() asm volatile("s_waitcnt vmcnt(48)" ::: "memory")
    if (loader) {
        DmaPtrs P; rw_dma_init(a, P, head, ib, lw, lane);
        for (int n = 0; n < SP_D; ++n) rw_dma_issue(P, lw, lane, lds0 + (unsigned)(n % SP_R) * SP_SLOT);
        SP_WAIT();
        SP_BAR();
        for (int n = 0; n < NC; ++n) {
            if (n + SP_D < NC) { rw_dma_issue(P, lw, lane, lds0 + (unsigned)((n + SP_D) % SP_R) * SP_SLOT); SP_WAIT(); }
            else asm volatile("s_waitcnt vmcnt(0)" ::: "memory");
            SP_BAR();
        }
    } else if (F.wave == 0) {
        bf16* YR = (bf16*)(a.ws + WS_YR) + head * 64 + 4 * (lane & 15) + ib;
        f32x4 H[4]; bf16x8 Hb[2];
#pragma unroll
        for (int t = 0; t < 4; ++t) H[t] = (f32x4){0.f, 0.f, 0.f, 0.f};
        Hb[0] = pk8s(H[0], H[1]); Hb[1] = pk8s(H[2], H[3]);
        ChunkOps C, N;
        SP_BAR();
        rw_slot_read(C, F.lds, ib, lane);
#define SP_STEP(CC, NN, n_) do { { const int nn = ((n_) + 1 < NC) ? (n_) + 1 : (n_); rw_slot_read(NN, F.lds + (nn % SP_R) * SP_SLOT, ib, lane); } \
            const bf16x4s Vb = __builtin_bit_cast(bf16x4s, CC.vb); \
            f32x4 U = MFMA32(CC.w1[0], Hb[0], bf4(CC.u0)); U = MFMA32(CC.w1[1], Hb[1], U); \
            f32x4 hk[4]; _Pragma("unroll") for (int t = 0; t < 4; ++t) hk[t] = MFMA16(CC.kt[t], Vb, H[t] * CC.d[t]); \
            f32x4 Y = MFMA32(CC.qa[0], Hb[0], bf4(CC.y0)); Y = MFMA32(CC.qa[1], Hb[1], Y); \
            const bf16x4s Ub = pk4s(U); \
            _Pragma("unroll") for (int t = 0; t < 4; ++t) H[t] = MFMA16(CC.bt[t], Ub, hk[t]); \
            Hb[0] = pk8s(H[0], H[1]); Hb[1] = pk8s(H[2], H[3]); \
            { const unsigned y01 = pk2(Y[0], Y[1]), y23 = pk2(Y[2], Y[3]); bf16* yp_ = YR + (size_t)(16 * (n_) + 4 * rg) * 1024; yp_[0] = (bf16)y01; yp_[1024] = (bf16)(y01 >> 16); yp_[2048] = (bf16)y23; yp_[3072] = (bf16)(y23 >> 16); } \
            asm volatile("s_barrier" ::: "memory");   } while (0)
        for (int n = 0; n < NC; n += 2) { SP_STEP(C, N, n); SP_STEP(N, C, n + 1); }
#undef SP_STEP
    } else {
        for (int n = 0; n < NC + 1; ++n) SP_BAR();
    }
#undef SP_BAR
#undef SP_WAIT
    asm volatile("s_waitcnt vmcnt(0)" ::: "memory"); __syncthreads();
}

__device__ __forceinline__ void p3_gn_chunk(const Args& a, int ch, int lane) {
    const int n = lane & 15, rg = lane >> 4, head = ch & 15, c0 = head * 64 + 4 * n; const int t0 = (ch >> 4) * 16 + 4 * rg;
    const bf16* YR = (const bf16*)(a.ws + WS_YR); const bf16* ZB = (const bf16*)(a.ws + WS_ZB); bf16* Y = (bf16*)(a.ws + WS_XN); const float* RK = (const float*)(a.ws + WS_RK);
    const f32x4 lw = ld4(a.in[16] + c0), lb = ld4(a.in[17] + c0);
    f32x4 vimg[4];
#pragma unroll
    for (int cb = 0; cb < 4; ++cb) vimg[cb] = bf4(*(const v2u*)(a.ws + WS_VS + (size_t)ch * 2048 + cb * 512 + lane * 8));
#pragma unroll
    for (int e = 0; e < 4; ++e) { const int t = t0 + e;
        f32x4 y = bf4(*(const v2u*)(YR + (size_t)t * 1024 + c0));
        const f32x4 g = bf4(*(const v2u*)(ZB + (size_t)t * 5120 + 4096 + c0)); const float rk = RK[(size_t)t * 16 + head];
        const float mean = row16_sum((y.x + y.y) + (y.z + y.w)) * (1.f / 64.f);
        y = y - mean;
        const float rstd = __builtin_amdgcn_rsqf(row16_sum((y.x * y.x + y.y * y.y) + (y.z * y.z + y.w * y.w)) * (1.f / 64.f) + GN_EPS);
        const f32x4 v = {vimg[0][e], vimg[1][e], vimg[2][e], vimg[3][e]};
        f32x4 o = y * rstd * lw + lb + v * rk;
#pragma unroll
        for (int k = 0; k < 4; ++k) o[k] *= g[k] * __builtin_amdgcn_rcpf(1.f + __expf(-g[k]));
        *(v2u*)(Y + (size_t)t * 2048 + c0) = pk4(o); }
}
__device__ __forceinline__ void p5_row2(const Args& a, int rowA, int rowB, int lane) {
    const float* SSQ = (const float*)(a.ws + WS_SSQ);
    float sa = lane < 32 ? SSQ[(size_t)rowA * 32 + lane] : 0.f, sb = lane < 32 ? SSQ[(size_t)rowB * 32 + lane] : 0.f;
    const v2u* mbA = (const v2u*)((const bf16*)(a.ws + WS_MB) + (size_t)rowA * 2048) + lane; const v2u* mbB = (const v2u*)((const bf16*)(a.ws + WS_MB) + (size_t)rowB * 2048) + lane;
    const f32x4* xA = (const f32x4*)(a.in[0] + (size_t)rowA * 2048) + lane; const f32x4* xB = (const f32x4*)(a.in[0] + (size_t)rowB * 2048) + lane;
    const f32x4* g1 = (const f32x4*)a.in[22] + lane; const f32x4* g2 = (const f32x4*)a.in[23] + lane;
    f32x4 v[8], w[8]; v2u ma[8], mb_[8];
#pragma unroll
    for (int jj = 0; jj < 8; ++jj) { v[jj] = xA[64 * jj]; w[jj] = xB[64 * jj]; ma[jj] = mbA[64 * jj]; mb_[jj] = mbB[64 * jj]; }
#pragma unroll
    for (int o = 1; o < 64; o <<= 1) { sa += __shfl_xor(sa, o); sb += __shfl_xor(sb, o); }
    const float ra = 1.f / sqrtf(sa * (1.f / DMODEL) + RMS_EPS), rb = 1.f / sqrtf(sb * (1.f / DMODEL) + RMS_EPS);
    float s = 0.f, t = 0.f;
#pragma unroll
    for (int jj = 0; jj < 8; ++jj) { const f32x4 gg = g1[64 * jj]; v[jj] = v[jj] + bf4(ma[jj]) * ra * gg; w[jj] = w[jj] + bf4(mb_[jj]) * rb * gg;
        s += (v[jj].x * v[jj].x + v[jj].y * v[jj].y) + (v[jj].z * v[jj].z + v[jj].w * v[jj].w); t += (w[jj].x * w[jj].x + w[jj].y * w[jj].y) + (w[jj].z * w[jj].z + w[jj].w * w[jj].w); }
#pragma unroll
    for (int o = 1; o < 64; o <<= 1) { s += __shfl_xor(s, o); t += __shfl_xor(t, o); }
    const float r0 = 1.f / sqrtf(s * (1.f / DMODEL) + RMS_EPS), r1 = 1.f / sqrtf(t * (1.f / DMODEL) + RMS_EPS);
    f32x4* oA = (f32x4*)(a.out + (size_t)rowA * 2048) + lane; f32x4* oB = (f32x4*)(a.out + (size_t)rowB * 2048) + lane;
    v2u* nA = (v2u*)((bf16*)(a.ws + WS_XN) + (size_t)rowA * 2048) + lane; v2u* nB = (v2u*)((bf16*)(a.ws + WS_XN) + (size_t)rowB * 2048) + lane;
#pragma unroll
    for (int jj = 0; jj < 8; ++jj) { const f32x4 gg = g2[64 * jj]; oA[64 * jj] = v[jj]; oB[64 * jj] = w[jj]; nA[64 * jj] = pk4(v[jj] * r0 * gg); nB[64 * jj] = pk4(w[jj] * r1 * gg); }
}

__global__ void __launch_bounds__(NTHR, 2) hybrid_fwd(Args args) {
    extern __shared__ __attribute__((aligned(16))) unsigned char lds[];
    Frame F; F.lds = (LAS unsigned char*)lds; F.wave = __builtin_amdgcn_readfirstlane(threadIdx.x >> 6);
    F.G = gridDim.x; F.gw = blockIdx.x * NWAVES + F.wave; F.NGW = F.G * NWAVES;
    unsigned char* ws = args.ws;
    volatile LAS unsigned* MISC = (volatile LAS unsigned*)(F.lds + MISC_OFF);
    unsigned* ctl = (unsigned*)(ws + WS_CTL);
    { int l_ = lane_id(); if (F.wave == 0 && l_ < 32) MISC[l_] = 0u; }
    __syncthreads();
    cg::this_grid().sync();
    XcdBarrier bar;
    { int l_ = lane_id(); bar = xcd_barrier_post(ctl + 4096, MISC + 8, F.wave * 64 + l_); }
#define GRID_BAR() do { int l_ = lane_id(); asm volatile("" : "+v"(l_)); xcd_barrier(bar, F.wave * 64 + l_); } while (0)

    PHASE_BEGIN();
    p0_prologue(F, args);
    GRID_BAR();
    {   pg8::Gemm g{(const pg8::bf16_t*)(ws + WS_XN), (const pg8::bf16_t*)(ws + WS_WIN), M, NPAD, DMODEL}; pg8::StaticOrder S; S.init(M, NPAD, F.G, (int)blockIdx.x);
        pg8::EpiZ E{(pg8::bf16_t*)(ws + WS_ZA), (pg8::bf16_t*)(ws + WS_ZB), (float*)(ws + WS_ZS)};
        pg8::gemm_phase<pg8::EpiZ, pg8::StaticOrder, PG8_ALIGN, PG8_SP2>(F.lds, g, S, E, F.wave); }
    GRID_BAR();
    PHASE_BEGIN();
    for (int g = blockIdx.x; g < T / 64; g += F.G) p2a_fgroup(F, args, g);
    GRID_BAR();
    PHASE_BEGIN();
    {   for (int g = blockIdx.x; g < T / 64; g += F.G) p2b_fgroup(F, args, g);
        for (int m = F.gw; m < M; m += F.NGW) p2_qknorm_row(args, m, F.lane);
        for (int tile = blockIdx.x; tile < T / 32; tile += F.G) p2_rwprep_tile(F, args, tile * 32); }
    GRID_BAR();
    PHASE_BEGIN();
    {   if ((int)blockIdx.x < NRWB) p3_rwkv_state(F, args);
        const attn_body::bf16* ZBq = (const attn_body::bf16*)(ws + WS_ZB); attn_body::bf16* Yo = (attn_body::bf16*)(ws + WS_XN) + 1024; const float* F2 = (const float*)(ws + WS_F2);
        float gapB; { const float bq = fabsf(args.in[19][F.lane]), bk = fabsf(args.in[20][F.lane]); float mq = bq, mk = bk;
#pragma unroll
            for (int o = 1; o < 64; o <<= 1) { mq = fmaxf(mq, __shfl_xor(mq, o)); mk = fmaxf(mk, __shfl_xor(mk, o)); }
            const float gv_ = 2.f * (64.f * mq * mk * 0.125f * LOG2E * 1.03f) + 48.f; asm volatile("v_readfirstlane_b32 %0, %1" : "=s"(gapB) : "v"(gv_)); }
        for (;;) {
            if (F.wave == 0) {
                const int ln_ = lane_id(); unsigned uu = 0u; if (ln_ == 0) uu = atomicAdd(ctl + 64, 1u);
                uu = (unsigned)__builtin_amdgcn_readfirstlane((int)uu);
                int tsw = 0;
                if (uu < (unsigned)(NH * (T / 256))) { const int qb_ = (T / 256 - 1) - (int)(uu >> 4), h_ = (int)(uu & 15);
                    const unsigned* F2h = (const unsigned*)(F2 + (size_t)h_ * T); const float lim = __uint_as_float(__hip_atomic_load(F2h + qb_ * 256, __ATOMIC_RELAXED, __HIP_MEMORY_SCOPE_AGENT)) + gapB; const int ntf = 4 * qb_;
                    for (int i = 0; i < 4; ++i) { const int jt = ln_ + 64 * i; const bool c = (jt < ntf) && (__uint_as_float(__hip_atomic_load(F2h + 64 * jt + 63, __ATOMIC_RELAXED, __HIP_MEMORY_SCOPE_AGENT)) >= lim); tsw += __popcll(__ballot(c)); }
                    tsw &= ~1; }
                if (ln_ == 0) { MISC[0] = uu; MISC[1] = (unsigned)tsw; }
            }
            __syncthreads();
            const unsigned u = (unsigned)__builtin_amdgcn_readfirstlane((int)MISC[0]); const int ts = __builtin_amdgcn_readfirstlane((int)MISC[1]);
            __syncthreads();
            if (u >= (unsigned)(NH * (T / 256))) break;
            const int qb = (T / 256 - 1) - (int)(u >> 4), h = (int)(u & 15);
            attn_body::attn_unit<8>(h, qb, ZBq, ZBq + 1024, ZBq + 2048, ZBq + 3072, Yo, F2 + (size_t)h * T, (char*)lds, F.wave, ts);
        }
        if ((int)blockIdx.x >= NRWB) {
            __syncthreads();
            pg8::Gemm g{(const pg8::bf16_t*)(ws + WS_PB), (const pg8::bf16_t*)(ws + WS_WPLE), M, DMODEL, DPLE}; pg8::StaticOrder S; S.init(M, DMODEL, F.G - NRWB, (int)blockIdx.x - NRWB);
            pg8::EpiBf16<0> E{(pg8::bf16_t*)(ws + WS_PLE), DMODEL, nullptr, 0, 0, 1.f};
            pg8::gemm_phase<pg8::EpiBf16<0>, pg8::StaticOrder, PG8_ALIGN, PG8_SP2>(F.lds, g, S, E, F.wave); } }
    GRID_BAR();
    PHASE_BEGIN();
    for (int ch = F.gw; ch < (T / 16) * NH; ch += F.NGW) p3_gn_chunk(args, ch, F.lane);
    GRID_BAR();
    {   pg8::Gemm g{(const pg8::bf16_t*)(ws + WS_XN), (const pg8::bf16_t*)(ws + WS_WOUT), M, DMODEL, DMODEL}; pg8::StaticOrder S; S.init(M, DMODEL, F.G, (int)blockIdx.x);
        pg8::EpiM E{(pg8::bf16_t*)(ws + WS_MB), (float*)(ws + WS_SSQ)};
        pg8::gemm_phase<pg8::EpiM, pg8::StaticOrder, PG8_ALIGN, PG8_SP2>(F.lds, g, S, E, F.wave); }
    GRID_BAR();
    PHASE_BEGIN();
    for (int m = F.gw; m < M; m += 2 * F.NGW) p5_row2(args, m, m + F.NGW, F.lane);
    GRID_BAR();
    {   pg8::Gemm g{(const pg8::bf16_t*)(ws + WS_XN), (const pg8::bf16_t*)(ws + WS_WGATE), M, DMODEL, DMODEL}; pg8::StaticOrder S; S.init(M, DMODEL, F.G, (int)blockIdx.x);
        pg8::EpiFinal E{args.out, (const pg8::bf16_t*)(ws + WS_PLE)};
        pg8::gemm_phase<pg8::EpiFinal, pg8::StaticOrder, PG8_ALIGN, PG8_SP2>(F.lds, g, S, E, F.wave); }
}

extern "C" void kernel_launch(void* const* d_in, const int* in_sizes, int n_in, void* d_out, int out_size, void* d_ws, size_t ws_size, hipStream_t stream) {
    static int grid = 0;
    if (grid == 0) {
        if (n_in != 26 || in_sizes[0] != M * DMODEL || out_size != M * DMODEL || ws_size < WS_END) { fprintf(stderr, "kernel_launch: unexpected shapes (n_in %d, in0 %d, out %d, ws %zu)\n", n_in, n_in > 0 ? in_sizes[0] : -1, out_size, ws_size); grid = -1; return; }
        int dev = 0, cus = 0, per_cu = 0;
        if (hipGetDevice(&dev) != hipSuccess || hipDeviceGetAttribute(&cus, hipDeviceAttributeMultiprocessorCount, dev) != hipSuccess) { grid = -1; return; }
        if (hipFuncSetAttribute((const void*)hybrid_fwd, hipFuncAttributeMaxDynamicSharedMemorySize, LDS_BYTES) != hipSuccess) { fprintf(stderr, "kernel_launch: hipFuncSetAttribute failed\n"); grid = -1; return; }
        if (hipOccupancyMaxActiveBlocksPerMultiprocessor(&per_cu, (const void*)hybrid_fwd, NTHR, LDS_BYTES) != hipSuccess || per_cu < 1) { fprintf(stderr, "kernel_launch: occupancy query says %d\n", per_cu); (void)hipGetLastError(); grid = -1; return; }
        grid = cus * per_cu;
        if (grid < NRWB) { fprintf(stderr, "kernel_launch: grid %d too small\n", grid); grid = -1; return; }
    }
    if (grid < 0) return;
    (void)hipMemsetAsync((char*)d_ws + WS_CTL, 0, 65536, stream);
    Args a{};
    for (int i = 0; i < 26; ++i) a.in[i] = (const float*)d_in[i];
    a.out = (float*)d_out; a.ws = (unsigned char*)d_ws;
    void* kargs[] = {&a};
    hipError_t e = hipLaunchCooperativeKernel((const void*)hybrid_fwd, dim3(grid), dim3(NTHR), kargs, LDS_BYTES, stream);
    if (e != hipSuccess) fprintf(stderr, "kernel_launch: cooperative launch failed: %s (grid %d)\n", hipGetErrorString(e), grid);
}
```

```cpp
#include <hip/hip_runtime.h>
#include <hip/hip_cooperative_groups.h>
#include <cstdio>
#include <cstdint>
namespace pg8 {
#define PG8_LAS __attribute__((address_space(3)))
typedef unsigned short bf16_t;
typedef short bf16x8 __attribute__((ext_vector_type(8)));
typedef float f32x4 __attribute__((ext_vector_type(4)));
typedef unsigned u32x4 __attribute__((ext_vector_type(4)));
constexpr int BM = 256, BK = 64, HALF = 128, HTB = HALF * BK * 2  , STAGE_BYTES = 8 * HTB, NXCD = 8, WGM = 8;

__host__ __device__ __forceinline__ int lds_byte(int r, int c) { const int st = (r >> 4) * 2 + (c >> 5), rr = r & 15, cc = c & 31, ob = rr * 64 + cc * 2; return st * 1024 + (ob ^ (((ob >> 9) & 1) << 5)); }
__host__ __device__ __forceinline__ void stage_rc(int b, int& R, int& C) { const int st = b / 1024, sb = b % 1024, swz = sb ^ (((sb >> 9) & 1) << 5); R = (st >> 1) * 16 + swz / 64; C = (st & 1) * 32 + (swz % 64) / 2; }
__host__ __device__ __forceinline__ int perm32(int rho) { const int n = rho >> 4, i = rho & 15; return 8 * (i >> 2) + 4 * n + (i & 3); }

struct Unit { int pm, pn; };
struct Gemm { const bf16_t* A; const bf16_t* Bt; int M, N, K; };

struct StaticOrder {
    int nM, nN, nwg, G, c;
    __host__ __device__ void init(int M, int N, int G_, int c_) { nM = M / BM; nN = N / BM; nwg = nM * nN; G = G_; c = c_; }
    __host__ __device__ bool next(int i, Unit& u) const {
        const long L = (long)i * G + c; if (L >= nwg) return false;
        int wgid = (int)L; { const int q = nwg / NXCD, r = nwg % NXCD, xcd = wgid % NXCD, off = wgid / NXCD; wgid = (xcd < r ? xcd * (q + 1) : r * (q + 1) + (xcd - r) * q) + off; }
        const int nig = WGM * nN, gid = wgid / nig, fm = gid * WGM, gsz = (nM - fm) < WGM ? (nM - fm) : WGM;
        u.pm = fm + ((wgid % nig) % gsz); u.pn = (wgid % nig) / gsz; return true;
    }
    __device__ __forceinline__ void a_ready(const Unit&) const {}
    __device__ __forceinline__ void done(const Unit&) const {}
};

__device__ __forceinline__ unsigned cvt_pk_bf16(float lo, float hi) { unsigned r; asm volatile("v_cvt_pk_bf16_f32 %0, %1, %2" : "=v"(r) : "v"(lo), "v"(hi)); return r; }
typedef float f32x2 __attribute__((ext_vector_type(2)));
__device__ __forceinline__ f32x2 gelu_pk(f32x2 v) {
    const f32x2 av = __builtin_elementwise_abs(v), d = av * 0.2316418882f + 1.0f;
    f32x2 t; t.x = __builtin_amdgcn_rcpf(d.x); t.y = __builtin_amdgcn_rcpf(d.y);
    f32x2 q = t * 0.5307027145f + (-0.7265760135f); q = q * t + 0.7107068705f; q = q * t + (-0.142248368f); q = q * t + 0.127414796f; q = q * t;
    const f32x2 s = (v * v) * (-0.72134752044f);
    f32x2 e; e.x = __builtin_amdgcn_exp2f(s.x); e.y = __builtin_amdgcn_exp2f(s.y);
    const f32x2 m = v * (q * e), r = v - m;
    f32x2 o; o.x = v.x < 0.f ? m.x : r.x; o.y = v.y < 0.f ? m.y : r.y; return o;
}

template <int ACT  > struct EpiBf16 {
    static constexpr bool PERM = true, AFTER_DRAIN = false; static_assert(ACT == 0 || ACT == 1, "EpiBf16: ACT is 0 (none) or 1 (gelu_pk)");
    bf16_t* O; int ldc; const float* bias; int split_cols; size_t split_stride; float scale0;
    __device__ __forceinline__ void operator()(const f32x4 (&acc)[2][2][4][2], const Unit& u, int wr, int wc, int fr, int fq) const {
        const int row0 = u.pm * BM + wr * 64 + fr; int colt = u.pn * BM; bf16_t* base = O;
        float sc = 1.f; if (split_cols) { const int t = colt / split_cols; base += (size_t)t * split_stride; colt -= t * split_cols; if (t == 0) sc = scale0; }
        const int col0 = colt + wc * 32 + 8 * fq, bcol0 = u.pn * BM + wc * 32 + 8 * fq;
        f32x4 bv[2][2];
#pragma unroll
        for (int bj = 0; bj < 2; ++bj)
#pragma unroll
            for (int n = 0; n < 2; ++n) bv[bj][n] = bias ? *(const f32x4*)(bias + bcol0 + bj * HALF + 4 * n) : (f32x4){0.f, 0.f, 0.f, 0.f};
#pragma unroll
        for (int ai = 0; ai < 2; ++ai)
#pragma unroll
            for (int m = 0; m < 4; ++m) { bf16_t* rowp = base + (size_t)(row0 + ai * HALF + m * 16) * ldc + col0;
#pragma unroll
                for (int bj = 0; bj < 2; ++bj) { f32x4 v0 = acc[ai][bj][m][0] + bv[bj][0], v1 = acc[ai][bj][m][1] + bv[bj][1];
                    if (ACT == 1) { f32x2 a = gelu_pk((f32x2){v0[0], v0[1]}), b = gelu_pk((f32x2){v0[2], v0[3]}), c = gelu_pk((f32x2){v1[0], v1[1]}), d = gelu_pk((f32x2){v1[2], v1[3]});
                        v0 = (f32x4){a.x, a.y, b.x, b.y}; v1 = (f32x4){c.x, c.y, d.x, d.y}; }
                    v0 = v0 * sc; v1 = v1 * sc; u32x4 w; w.x = cvt_pk_bf16(v0[0], v0[1]); w.y = cvt_pk_bf16(v0[2], v0[3]); w.z = cvt_pk_bf16(v1[0], v1[1]); w.w = cvt_pk_bf16(v1[2], v1[3]);
                    *(u32x4*)(rowp + bj * HALF) = w; } }
    }
};
template <class Epi, class Sched, bool ALIGN_EPI = false, bool SP2 = false>
__device__ __forceinline__ void gemm_phase(PG8_LAS unsigned char* lds, const Gemm g, const Sched& S, const Epi& E, const int wave_) {
    int tid_ = wave_ * 64 + ({ int l__; asm volatile("v_mbcnt_lo_u32_b32 %0, -1, 0\n\tv_mbcnt_hi_u32_b32 %0, -1, %0" : "=v"(l__)); l__; }); asm volatile("" : "+v"(tid_));
    const int tid = tid_, wid = __builtin_amdgcn_readfirstlane(tid >> 6), lane = tid & 63, wr = wid >> 2, wc = wid & 3, fr = lane & 15, fq = lane >> 4;
    const int K = g.K, nt = K / BK;
    unsigned voffA[2], voffB[2];
#pragma unroll
    for (int i = 0; i < 2; ++i) { int R, C; stage_rc(tid * 16 + i * 8192, R, C); const int Rb = Epi::PERM ? ((R & ~31) + perm32(R & 31)) : R;
        voffA[i] = (unsigned)(R * K + C) * 2u; voffB[i] = (unsigned)(Rb * K + C) * 2u; }
    const size_t kstep = (size_t)(BK * 2);
    const size_t hstep = (size_t)HALF * K * 2;
    const size_t tstep = 2 * hstep;
    const unsigned ldsw = (unsigned)wid * 1024u;
    const int aoff = lds_byte(wr * 64 + fr, fq * 8), boff = lds_byte(wc * 32 + fr, fq * 8);
#define PG8_SA(b, h) (((b) * 2 + (h)) * HTB)
#define PG8_SB(b, h) ((4 + (b) * 2 + (h)) * HTB)
#define PG8_STAGE(bufoff, gbase, voff) do { _Pragma("unroll") for (int _i = 0; _i < 2; ++_i) \
        __builtin_amdgcn_global_load_lds((const unsigned*)((const char*)(gbase) + (voff)[_i]), (PG8_LAS unsigned*)(lds + (bufoff) + ldsw + _i * 8192), 16, 0, 0); } while (0)
#define PG8_LDA(dst, b, h) do { _Pragma("unroll") for (int m = 0; m < 4; ++m) _Pragma("unroll") for (int k = 0; k < 2; ++k) dst[m][k] = *(const PG8_LAS bf16x8*)(lds + PG8_SA(b, h) + aoff + m * 2048 + k * 1024); } while (0)
#define PG8_LDB(dst, b, h) do { _Pragma("unroll") for (int n = 0; n < 2; ++n) _Pragma("unroll") for (int k = 0; k < 2; ++k) dst[n][k] = *(const PG8_LAS bf16x8*)(lds + PG8_SB(b, h) + boff + n * 2048 + k * 1024); } while (0)
#define PG8_MMA(ai, bj, At, Bt) do { __builtin_amdgcn_s_setprio(1); _Pragma("unroll") for (int m = 0; m < 4; ++m) _Pragma("unroll") for (int n = 0; n < 2; ++n) _Pragma("unroll") for (int k = 0; k < 2; ++k) \
        acc[ai][bj][m][n] = __builtin_amdgcn_mfma_f32_16x16x32_bf16(Bt[n][k], At[m][k], acc[ai][bj][m][n], 0, 0, 0); __builtin_amdgcn_s_setprio(0); } while (0)
#define PG8_WAIT_V(n) asm volatile("s_waitcnt vmcnt(" #n ")" ::: "memory")
#define PG8_WAIT_L(n) asm volatile("s_waitcnt lgkmcnt(" #n ")" ::: "memory")
#define PG8_BAR __builtin_amdgcn_s_barrier()
#define PG8_SCHED __builtin_amdgcn_sched_barrier(0)
    Unit cur, nxt; int ui = 0;
    if (!S.next(0, cur)) return;
    f32x4 acc[2][2][4][2];
#pragma unroll
    for (int a = 0; a < 2; ++a)
#pragma unroll
        for (int b = 0; b < 2; ++b)
#pragma unroll
            for (int m = 0; m < 4; ++m)
#pragma unroll
                for (int n = 0; n < 2; ++n) acc[a][b][m][n] = (f32x4){0.f, 0.f, 0.f, 0.f};
    bf16x8 At[4][2], B0[2][2], B1[2][2];
    const char* cA = (const char*)g.A + (size_t)cur.pm * tstep; const char* cB = (const char*)g.Bt + (size_t)cur.pn * tstep;
    S.a_ready(cur);
    if constexpr (SP2) {
        PG8_STAGE(PG8_SB(0, 0), cB, voffB); PG8_STAGE(PG8_SB(0, 1), cB + hstep, voffB); PG8_STAGE(PG8_SA(0, 0), cA, voffA); PG8_STAGE(PG8_SA(0, 1), cA + hstep, voffA);
        if (wr == 1) PG8_BAR;
        PG8_WAIT_V(2); PG8_BAR;
        PG8_STAGE(PG8_SB(1, 0), cB + kstep, voffB); PG8_STAGE(PG8_SA(1, 0), cA + kstep, voffA); PG8_STAGE(PG8_SB(1, 1), cB + hstep + kstep, voffB);
        PG8_WAIT_V(6); PG8_BAR;
    } else {
        PG8_STAGE(PG8_SB(0, 0), cB, voffB); PG8_STAGE(PG8_SA(0, 0), cA, voffA); PG8_STAGE(PG8_SB(0, 1), cB + hstep, voffB); PG8_STAGE(PG8_SA(0, 1), cA + hstep, voffA);
        if (wr == 1) PG8_BAR;
        PG8_WAIT_V(4); PG8_BAR;
        PG8_STAGE(PG8_SB(1, 0), cB + kstep, voffB); PG8_STAGE(PG8_SA(1, 0), cA + kstep, voffA); PG8_STAGE(PG8_SB(1, 1), cB + hstep + kstep, voffB);
        PG8_WAIT_V(6); PG8_BAR;
    }
    for (;;) {
        const bool has_next = S.next(ui + 1, nxt);
        const char* nA = has_next ? (const char*)g.A + (size_t)nxt.pm * tstep : cA; const char* nB = has_next ? (const char*)g.Bt + (size_t)nxt.pn * tstep : cB;
        for (int t = 0; t < nt; t += 2) {
            const bool last = (t == nt - 2);
            const char* a1 = cA + (size_t)(t + 1) * kstep;
            const char* a2 = last ? nA : cA + (size_t)(t + 2) * kstep; const char* b2 = last ? nB : cB + (size_t)(t + 2) * kstep;
            const char* a3 = a2 + kstep; const char* b3 = b2 + kstep;
            if (last && has_next) S.a_ready(nxt);
            if constexpr (SP2) {
            PG8_LDB(B0, 0, 0); PG8_LDB(B1, 0, 1); PG8_SCHED; PG8_LDA(At, 0, 0); PG8_STAGE(PG8_SA(1, 1), a1 + hstep, voffA);
            PG8_WAIT_V(8); PG8_WAIT_L(0); PG8_BAR; PG8_MMA(0, 0, At, B0); PG8_MMA(0, 1, At, B1); PG8_BAR; PG8_SCHED;
            PG8_LDA(At, 0, 1); PG8_STAGE(PG8_SB(0, 0), b2, voffB); PG8_STAGE(PG8_SB(0, 1), b2 + hstep, voffB); PG8_STAGE(PG8_SA(0, 0), a2, voffA);
            PG8_WAIT_V(8); PG8_WAIT_L(0); PG8_BAR; PG8_MMA(1, 0, At, B0); PG8_MMA(1, 1, At, B1); PG8_BAR; PG8_SCHED;
            PG8_LDB(B0, 1, 0); PG8_LDB(B1, 1, 1); PG8_SCHED; PG8_LDA(At, 1, 0); PG8_STAGE(PG8_SA(0, 1), a2 + hstep, voffA);
            PG8_WAIT_V(8); PG8_WAIT_L(0); PG8_BAR; PG8_MMA(0, 0, At, B0); PG8_MMA(0, 1, At, B1); PG8_BAR; PG8_SCHED;
            PG8_LDA(At, 1, 1); PG8_STAGE(PG8_SB(1, 0), b3, voffB); PG8_STAGE(PG8_SB(1, 1), b3 + hstep, voffB); PG8_STAGE(PG8_SA(1, 0), a3, voffA);
            PG8_WAIT_V(8); PG8_WAIT_L(0); PG8_BAR; PG8_MMA(1, 0, At, B0); PG8_MMA(1, 1, At, B1); PG8_BAR; PG8_SCHED;
            } else {
            PG8_LDB(B0, 0, 0); PG8_SCHED; PG8_LDA(At, 0, 0); PG8_STAGE(PG8_SA(1, 1), a1 + hstep, voffA);
            PG8_WAIT_L(8); PG8_BAR; PG8_WAIT_L(0); PG8_MMA(0, 0, At, B0); PG8_BAR; PG8_SCHED;
            PG8_LDB(B1, 0, 1); PG8_STAGE(PG8_SB(0, 0), b2, voffB);
            PG8_BAR; PG8_WAIT_L(0); PG8_MMA(0, 1, At, B1); PG8_BAR;
            PG8_LDA(At, 0, 1); PG8_STAGE(PG8_SA(0, 0), a2, voffA);
            PG8_BAR; PG8_WAIT_L(0); PG8_MMA(1, 0, At, B0); PG8_BAR; PG8_SCHED;
            PG8_STAGE(PG8_SB(0, 1), b2 + hstep, voffB);
            PG8_WAIT_V(6); PG8_BAR; PG8_MMA(1, 1, At, B1); PG8_BAR;
            PG8_LDB(B0, 1, 0); PG8_SCHED; PG8_LDA(At, 1, 0); PG8_STAGE(PG8_SA(0, 1), a2 + hstep, voffA);
            PG8_WAIT_L(8); PG8_BAR; PG8_WAIT_L(0); PG8_MMA(0, 0, At, B0); PG8_BAR; PG8_SCHED;
            PG8_LDB(B1, 1, 1); PG8_STAGE(PG8_SB(1, 0), b3, voffB);
            PG8_BAR; PG8_WAIT_L(0); PG8_MMA(0, 1, At, B1); PG8_BAR;
            PG8_LDA(At, 1, 1); PG8_STAGE(PG8_SA(1, 0), a3, voffA);
            PG8_BAR; PG8_WAIT_L(0); PG8_MMA(1, 0, At, B0); PG8_BAR; PG8_SCHED;
            PG8_STAGE(PG8_SB(1, 1), b3 + hstep, voffB);
            PG8_WAIT_V(6); PG8_BAR; PG8_MMA(1, 1, At, B1); PG8_BAR;
            }
        }
        if constexpr (ALIGN_EPI) { if (wr == 0) PG8_BAR; }
        if constexpr (!Epi::AFTER_DRAIN) { int l_; asm volatile("v_mbcnt_lo_u32_b32 %0, -1, 0\n\tv_mbcnt_hi_u32_b32 %0, -1, %0" : "=v"(l_));
            E(acc, cur, wr, wc, l_ & 15, l_ >> 4); S.done(cur); }
        if (!has_next) break;
#pragma unroll
        for (int a = 0; a < 2; ++a)
#pragma unroll
            for (int b = 0; b < 2; ++b)
#pragma unroll
                for (int m = 0; m < 4; ++m)
#pragma unroll
                    for (int n = 0; n < 2; ++n) acc[a][b][m][n] = (f32x4){0.f, 0.f, 0.f, 0.f};
        cur = nxt; cA = nA; cB = nB; ++ui;
        if constexpr (ALIGN_EPI) { if (wr == 1) PG8_BAR; }
    }
    PG8_WAIT_V(0);
    if constexpr (!ALIGN_EPI) { if (wr == 0) PG8_BAR; }
    PG8_BAR;
    if constexpr (Epi::AFTER_DRAIN) { E.fused(acc, cur, wr, wc, fr, fq, lds, wid, lane); S.done(cur); }
#undef PG8_SA
#undef PG8_SB
#undef PG8_STAGE
#undef PG8_LDA
#undef PG8_LDB
#undef PG8_MMA
#undef PG8_WAIT_V
#undef PG8_WAIT_L
#undef PG8_BAR
#undef PG8_SCHED
}
}

#ifndef PG8_SP2
#define PG8_SP2 true
#endif
#ifndef PG8_ALIGN
#define PG8_ALIGN true
#endif
namespace pg8 {
struct EpiZ {
    static constexpr bool PERM = true, AFTER_DRAIN = false;
    bf16_t* ZA; bf16_t* ZB; float* ZS;
    __device__ __forceinline__ void operator()(const f32x4 (&acc)[2][2][4][2], const Unit& u, int wr, int wc, int fr, int fq) const {
        const int row0 = u.pm * BM + wr * 64 + fr; const int colt = u.pn * BM; const int cl = wc * 32 + 8 * fq;
        if (colt >= 8192) {
#pragma unroll
            for (int ai = 0; ai < 2; ++ai)
#pragma unroll
                for (int m = 0; m < 4; ++m) { float* rowp = ZS + (size_t)(row0 + ai * HALF + m * 16) * 256 + cl;
#pragma unroll
                    for (int bj = 0; bj < 2; ++bj) { *(f32x4*)(rowp + bj * HALF) = acc[ai][bj][m][0]; *(f32x4*)(rowp + bj * HALF + 4) = acc[ai][bj][m][1]; } }
        } else {
            bf16_t* base; int ldc, c0; if (colt < 3072) { base = ZA; ldc = 3072; c0 = colt; } else { base = ZB; ldc = 5120; c0 = colt - 3072; }
#pragma unroll
            for (int ai = 0; ai < 2; ++ai)
#pragma unroll
                for (int m = 0; m < 4; ++m) { bf16_t* rowp = base + (size_t)(row0 + ai * HALF + m * 16) * ldc + c0 + cl;
#pragma unroll
                    for (int bj = 0; bj < 2; ++bj) { const f32x4 v0 = acc[ai][bj][m][0], v1 = acc[ai][bj][m][1]; u32x4 w; w.x = cvt_pk_bf16(v0[0], v0[1]); w.y = cvt_pk_bf16(v0[2], v0[3]); w.z = cvt_pk_bf16(v1[0], v1[1]); w.w = cvt_pk_bf16(v1[2], v1[3]);
                        *(u32x4*)(rowp + bj * HALF) = w; } }
        }
    }
};
struct EpiM {
    static constexpr bool PERM = true, AFTER_DRAIN = false;
    bf16_t* O; float* SSQ;
    __device__ __forceinline__ void operator()(const f32x4 (&acc)[2][2][4][2], const Unit& u, int wr, int wc, int fr, int fq) const {
        const int row0 = u.pm * BM + wr * 64 + fr; const int col0 = u.pn * BM + wc * 32 + 8 * fq;
#pragma unroll
        for (int ai = 0; ai < 2; ++ai)
#pragma unroll
            for (int m = 0; m < 4; ++m) { const int row = row0 + ai * HALF + m * 16; bf16_t* rowp = O + (size_t)row * 2048 + col0; float s = 0.f;
#pragma unroll
                for (int bj = 0; bj < 2; ++bj) { const f32x4 v0 = acc[ai][bj][m][0], v1 = acc[ai][bj][m][1];
                    s += (v0[0] * v0[0] + v0[1] * v0[1]) + (v0[2] * v0[2] + v0[3] * v0[3]) + (v1[0] * v1[0] + v1[1] * v1[1]) + (v1[2] * v1[2] + v1[3] * v1[3]);
                    u32x4 w; w.x = cvt_pk_bf16(v0[0], v0[1]); w.y = cvt_pk_bf16(v0[2], v0[3]); w.z = cvt_pk_bf16(v1[0], v1[1]); w.w = cvt_pk_bf16(v1[2], v1[3]);
                    *(u32x4*)(rowp + bj * HALF) = w; }
                s += __shfl_xor(s, 16); s += __shfl_xor(s, 32);
                if (fq == 0) SSQ[(size_t)row * 32 + u.pn * 4 + wc] = s; }
    }
};
struct EpiFinal {
    static constexpr bool PERM = true, AFTER_DRAIN = false;
    float* OUT; const bf16_t* PLE;
    __device__ __forceinline__ void operator()(const f32x4 (&acc)[2][2][4][2], const Unit& u, int wr, int wc, int fr, int fq) const {
        const int row0 = u.pm * BM + wr * 64 + fr; const int col0 = u.pn * BM + wc * 32 + 8 * fq;
#pragma unroll
        for (int ai = 0; ai < 2; ++ai)
#pragma unroll
            for (int m = 0; m < 4; ++m) { const size_t off = (size_t)(row0 + ai * HALF + m * 16) * 2048 + col0;
#pragma unroll
                for (int bj = 0; bj < 2; ++bj) { const f32x4 a0 = acc[ai][bj][m][0], a1 = acc[ai][bj][m][1];
                    const f32x4 x0 = *(const f32x4*)(OUT + off + bj * HALF), x1 = *(const f32x4*)(OUT + off + bj * HALF + 4); const u32x4 pl = *(const u32x4*)(PLE + off + bj * HALF);
                    f32x4 o0, o1;
#pragma unroll
                    for (int e = 0; e < 2; ++e) { const float pl0 = __uint_as_float(pl[e] << 16), pl1 = __uint_as_float(pl[e] & 0xffff0000u), ph0 = __uint_as_float(pl[2 + e] << 16), ph1 = __uint_as_float(pl[2 + e] & 0xffff0000u);
                        o0[2 * e] = x0[2 * e] + pl0 * __builtin_amdgcn_rcpf(1.f + __expf(-a0[2 * e])); o0[2 * e + 1] = x0[2 * e + 1] + pl1 * __builtin_amdgcn_rcpf(1.f + __expf(-a0[2 * e + 1]));
                        o1[2 * e] = x1[2 * e] + ph0 * __builtin_amdgcn_rcpf(1.f + __expf(-a1[2 * e])); o1[2 * e + 1] = x1[2 * e + 1] + ph1 * __builtin_amdgcn_rcpf(1.f + __expf(-a1[2 * e + 1])); }
                    *(f32x4*)(OUT + off + bj * HALF) = o0; *(f32x4*)(OUT + off + bj * HALF + 4) = o1; asm volatile("" ::: "memory"); } }
    }
};
}
#include <hip/hip_bf16.h>
#include <cmath>
namespace attn_body {
using bf16=__hip_bfloat16;
using bf16x8=__attribute__((ext_vector_type(8)))short;
using s16x4=__attribute__((ext_vector_type(4)))short;
using f32x16=__attribute__((ext_vector_type(16)))float;
using u32x4=__attribute__((ext_vector_type(4)))unsigned;
using f32x4v=__attribute__((ext_vector_type(4)))float;
constexpr int BATCH=1,NHEAD=16,SEQ=16384,D=64,DM=5120,PO=2048;
constexpr int NW=8,QBLK=32,QB=QBLK*NW,KVBLK=64,NQB=SEQ/QB;
constexpr int ATTN_PITCH=DM, ATTN_UNIT_ROWS=QB;
__device__ __forceinline__ int crow(int r,int hi){return (r&3)+8*(r>>2)+4*hi;}
#define SBAR() __builtin_amdgcn_sched_barrier(0)
__device__ __forceinline__ void cmask(f32x16&p0,f32x16&p1,int jb,int qrel,int hi){
  const float NEG=-INFINITY; int dq=qrel-(64*jb+4*hi); asm volatile("":"+v"(dq));
  #pragma unroll
  for(int r=0;r<16;++r){const int c=(r&3)+8*(r>>2); if(c>dq)p0[r]=NEG; if(c+32>dq)p1[r]=NEG;}
}

constexpr int NSLOT=3, SLOTB=8192;
constexpr int LDS_K=0, LDS_V=NSLOT*SLOTB, LDS_WS=2*NSLOT*SLOTB, LDS_OST=LDS_WS+NW*64*4, LDS_F=LDS_OST+NW*4096,LDS_BYTES=LDS_F+SEQ*4;
constexpr float C2=0.125f*1.4426950408889634f;
__device__ __forceinline__ void glds16(const void*gsrc,unsigned lds_dst){unsigned keep;
  asm volatile("s_mov_b32 %0, m0\n\ts_mov_b32 m0, %2\n\ts_nop 0\n\tglobal_load_lds_dwordx4 %1, off\n\ts_mov_b32 m0, %0":"=&s"(keep):"v"(gsrc),"s"(lds_dst):"memory");}
__device__ __forceinline__ float max3f(float a,float b,float c){float r;asm("v_max3_f32 %0, %1, %2, %3":"=v"(r):"v"(a),"v"(b),"v"(c));return r;}
__device__ __forceinline__ float max2f(float a,float b){float r;asm("v_max_f32_e32 %0, %1, %2":"=v"(r):"v"(a),"v"(b));return r;}
__device__ __forceinline__ float fadd_s(float a,float b){float r;asm("v_add_f32_e32 %0, %1, %2":"=v"(r):"v"(a),"v"(b));return r;}
__device__ __forceinline__ float fsub_s(float a,float b){float r;asm("v_sub_f32_e32 %0, %1, %2":"=v"(r):"v"(a),"v"(b));return r;}
typedef float f32x2_t __attribute__((ext_vector_type(2))); typedef __bf16 bf16x2_t __attribute__((ext_vector_type(2)));
__device__ __forceinline__ unsigned cvtpk_s(float lo,float hi){f32x2_t v={lo,hi};bf16x2_t b=__builtin_convertvector(v,bf16x2_t);return __builtin_bit_cast(unsigned,b);}
#define WAIT_BAR(N) asm volatile("s_waitcnt vmcnt(" #N ") lgkmcnt(0)\n\ts_barrier":::"memory")

__device__ __forceinline__ void qkt(f32x16&p0,f32x16&p1,const char*Kslot,const bf16x8*qr,int r32,int hi){
  const char*kb=Kslot+hi*1024+r32*16;
  #pragma unroll
  for(int d0=0;d0<4;++d0){
    const bf16x8 b0=*reinterpret_cast<const bf16x8*>(kb+d0*2048);
    const bf16x8 b1=*reinterpret_cast<const bf16x8*>(kb+d0*2048+512);
    {p0=__builtin_amdgcn_mfma_f32_32x32x16_bf16(b0,qr[d0],p0,0,0,0);p1=__builtin_amdgcn_mfma_f32_32x32x16_bf16(b1,qr[d0],p1,0,0,0);}}
}
typedef __attribute__((address_space(3))) const char* lds_cptr;
typedef short v4i16_t __attribute__((ext_vector_type(4)));
__device__ __forceinline__ void kload8(bf16x8*kf,lds_cptr kp){
  kf[0]=*(const __attribute__((address_space(3))) bf16x8*)(kp);      kf[1]=*(const __attribute__((address_space(3))) bf16x8*)(kp+512);
  kf[2]=*(const __attribute__((address_space(3))) bf16x8*)(kp+2048); kf[3]=*(const __attribute__((address_space(3))) bf16x8*)(kp+2560);
  kf[4]=*(const __attribute__((address_space(3))) bf16x8*)(kp+4096); kf[5]=*(const __attribute__((address_space(3))) bf16x8*)(kp+4608);
  kf[6]=*(const __attribute__((address_space(3))) bf16x8*)(kp+6144); kf[7]=*(const __attribute__((address_space(3))) bf16x8*)(kp+6656);
}
__device__ __forceinline__ void kload2(bf16x8*kf,lds_cptr kp,int j){ kf[2*j]=*(const __attribute__((address_space(3))) bf16x8*)(kp+j*2048); kf[2*j+1]=*(const __attribute__((address_space(3))) bf16x8*)(kp+j*2048+512); }
__device__ __forceinline__ s16x4 vtr(lds_cptr p){ return __builtin_bit_cast(s16x4,__builtin_amdgcn_ds_read_tr16_b64_v4i16((__attribute__((address_space(3))) v4i16_t*)p)); }
__device__ __forceinline__ float rowmax(const f32x16&p0,const f32x16&p1){
  float a=max3f(p0[0],p0[1],p1[0]),b=max3f(p0[2],p0[3],p1[1]);a=max3f(a,p1[2],p1[3]);
  #pragma unroll
  for(int r=4;r<16;r+=4){a=max3f(a,p0[r],p0[r+1]);b=max3f(b,p0[r+2],p0[r+3]);a=max3f(a,p1[r],p1[r+1]);b=max3f(b,p1[r+2],p1[r+3]);}
  const float m=max2f(a,b);
  auto rr=__builtin_amdgcn_permlane32_swap(__float_as_uint(m),__float_as_uint(m),false,false);
  return max2f(__uint_as_float(rr[0]),__uint_as_float(rr[1]));
}
__device__ __forceinline__ void pv(f32x16*o,int vb,bf16x8 pa0,bf16x8 pa1,bf16x8 pa2,bf16x8 pa3){
  #pragma unroll
  for(int d0=0;d0<2;++d0){s16x4 lo[4],hi[4];
    #pragma unroll
    for(int ks=0;ks<4;++ks){
      asm volatile("ds_read_b64_tr_b16 %0,%1 offset:%c2":"=&v"(lo[ks]):"v"(vb),"i"(d0*4096+ks*1024):"memory");
      asm volatile("ds_read_b64_tr_b16 %0,%1 offset:%c2":"=&v"(hi[ks]):"v"(vb),"i"(d0*4096+ks*1024+512):"memory");}
    asm volatile("s_waitcnt lgkmcnt(0)":::"memory");SBAR();
    #define PK(k) (bf16x8){lo[k][0],lo[k][1],lo[k][2],lo[k][3],hi[k][0],hi[k][1],hi[k][2],hi[k][3]}
    o[d0]=__builtin_amdgcn_mfma_f32_32x32x16_bf16(pa0,PK(0),o[d0],0,0,0);
    o[d0]=__builtin_amdgcn_mfma_f32_32x32x16_bf16(pa1,PK(1),o[d0],0,0,0);
    o[d0]=__builtin_amdgcn_mfma_f32_32x32x16_bf16(pa2,PK(2),o[d0],0,0,0);
    o[d0]=__builtin_amdgcn_mfma_f32_32x32x16_bf16(pa3,PK(3),o[d0],0,0,0);
    #undef PK
  }
}

#ifndef ATTN_STORE16
#define ATTN_STORE16(p,v) (*(u32x4*)(p)=(v))
#endif
template<int THRL> __device__ __forceinline__ void attn_unit(int h,int qb,const bf16*Q,const bf16*__restrict__ K,const bf16*__restrict__ V,const bf16*__restrict__ G,bf16*O,const float*__restrict__ F2h,char*shm,const int wave_,const int ts){
  const int wid=wave_; int lane_=({ int l__; asm volatile("v_mbcnt_lo_u32_b32 %0, -1, 0\n\tv_mbcnt_hi_u32_b32 %0, -1, %0" : "=v"(l__)); l__; }); asm volatile("":"+v"(lane_)); const int lane=lane_,tid=wid*64+lane,r32=lane&31,hi=lane>>5;
  const long rowbase=0; const int q0=qb*QB;
  const bf16*Qw=Q+(rowbase+q0+wid*QBLK)*DM+h*D;
  const bf16*Kh=K+(long)ts*KVBLK*DM+h*D,*Vh=V+(long)ts*KVBLK*DM+h*D;
  const unsigned lds0=(unsigned)(uintptr_t)shm;
  float*wsf=(float*)(shm+LDS_WS)+wid*64;
  const bf16*ksrc=Kh+(long)lane*DM+wid*8;
  const bf16*vsrc=Vh+(long)(16*(wid&3)+(lane>>2))*DM+(wid>>2)*32+(lane&3)*8;
  const unsigned kdst=lds0+LDS_K+wid*1024, vdst=lds0+LDS_V+wid*1024;
  #define DMA_K(t,slot) glds16(ksrc+(long)(t)*KVBLK*DM,(unsigned)__builtin_amdgcn_readfirstlane(kdst+(slot)))
  #define DMA_V(t,slot) glds16(vsrc+(long)(t)*KVBLK*DM,(unsigned)__builtin_amdgcn_readfirstlane(vdst+(slot)))
  const int vb0=(int)(lds0+LDS_V)+((lane>>4)&1)*32+(lane&3)*8+(4*hi+((lane&15)>>2))*64;
  const char*Kbase=shm+LDS_K; bf16x8 kf[8];
  const lds_cptr shm3=(lds_cptr)shm; const lds_cptr kp0=shm3+LDS_K+hi*1024+r32*16; const lds_cptr vp0=shm3+LDS_V+((lane>>4)&1)*32+(lane&3)*8+(4*hi+((lane&15)>>2))*64;
  const int NT=(q0+QB)/KVBLK-ts;
  { typedef __attribute__((address_space(3))) f32x4v* lf4; const f32x4v*src=(const f32x4v*)(F2h+ts*KVBLK); lf4 dst=(lf4)((__attribute__((address_space(3))) char*)shm3+LDS_F); for(int i=tid;i<NT*16;i+=NW*64)dst[i]=src[i]; }
  const float fq2=F2h[q0+wid*QBLK+r32];
  asm volatile("s_waitcnt vmcnt(0) lgkmcnt(0)":::"memory");
  DMA_K(0,0);DMA_V(0,0);DMA_K(1,SLOTB);
  bf16x8 qr[4];
  #pragma unroll
  for(int d0=0;d0<4;++d0)qr[d0]=*reinterpret_cast<const bf16x8*>(&Qw[(long)r32*DM+d0*16+hi*8]);
  float fref=fq2  ,l_reg=0.f;f32x16 o[2];o[0]=f32x16{};o[1]=f32x16{};
  const int qrel=wid*QBLK+r32;
  typedef __attribute__((address_space(3))) const f32x4v* lds_f4c; const lds_f4c fbase=(lds_f4c)(shm3+LDS_F+16*hi);
  #define FLOAD(P0,P1,t) do{ const lds_f4c fp_=fbase+(t)*16; _Pragma("unroll") for(int j_=0;j_<4;++j_){ const f32x4v a_=fp_[2*j_], b_=fp_[8+2*j_]; \
      P0[4*j_]=a_[0];P0[4*j_+1]=a_[1];P0[4*j_+2]=a_[2];P0[4*j_+3]=a_[3]; P1[4*j_]=b_[0];P1[4*j_+1]=b_[1];P1[4*j_+2]=b_[2];P1[4*j_+3]=b_[3]; } }while(0)
  #define FSUB(P0,P1) do{ const float base_=fref; _Pragma("unroll") for(int r=0;r<16;++r){P0[r]=base_-P0[r];P1[r]=base_-P1[r];} }while(0)
  #define CMASK(P0,P1,t) do{int jb_=(t)-(NT-4); if(jb_>=0)cmask(P0,P1,jb_,qrel,hi);}while(0)
  bool resc=false;
  #define START(P0,P1) do{ const float rm=rowmax(P0,P1); resc=false; \
    { const float dl=rm; fref=fsub_s(fref,dl); \
      _Pragma("unroll") for(int r=0;r<16;++r){P0[r]=fsub_s(P0[r],dl);P1[r]=fsub_s(P1[r],dl);} \
      } \
    _Pragma("unroll") for(int r=0;r<16;++r)P0[r]=__builtin_amdgcn_exp2f(P0[r]); }while(0)
  #define RESC() do{ if(resc){ asm volatile("s_waitcnt lgkmcnt(0)":::"memory"); \
      _Pragma("unroll") for(int d_=0;d_<2;++d_) _Pragma("unroll") for(int r=0;r<16;++r)o[d_][r]*=wsf[crow(r,hi)]; } }while(0)
  f32x16 pA0,pA1,pB0,pB1;
  int sl_prev=0,sl_cur=0,sl_next=SLOTB;
  #define ROT() do{sl_prev=sl_cur;sl_cur=sl_next;sl_next=(sl_next==(NSLOT-1)*SLOTB)?0:sl_next+SLOTB;}while(0)
  DMA_K(2,2*SLOTB);
  WAIT_BAR(3);
  FLOAD(pA0,pA1,0); FSUB(pA0,pA1); qkt(pA0,pA1,Kbase,qr,r32,hi);asm volatile("s_nop 15\n\ts_nop 7":"+v"(pA0),"+v"(pA1));CMASK(pA0,pA1,0);
  START(pA0,pA1);
  _Pragma("unroll") for(int r=0;r<16;++r)pA1[r]=__builtin_amdgcn_exp2f(pA1[r]);
  WAIT_BAR(0);
  DMA_K(3,0);DMA_V(1,SLOTB);
  ROT();
  kload8(kf,kp0+sl_cur); FLOAD(pB0,pB1,1);
  WAIT_BAR(2);
  s16x4 vlo[8],vhi[8]; u32x4 pw0,pw1,pw2,pw3;
  #define PKW(P,B) cvtpk_s(P[B],P[B+1])
  #define PAF(k) __builtin_bit_cast(bf16x8,pw##k)
  #define VFR(i) (bf16x8){vlo[i][0],vlo[i][1],vlo[i][2],vlo[i][3],vhi[i][0],vhi[i][1],vhi[i][2],vhi[i][3]}
  #define PIN(x) asm volatile("":"+v"(x))
  #define MX3(a,b,c) __builtin_fmaxf(__builtin_fmaxf((a),(b)),(c))
  #define GAPA(MF,A0,A1,A2,A3,W0,W1,PW) do{ MF; sacc+=A0; sacc+=A1; sacc+=A2; sacc+=A3; PIN(sacc); W0; W1; PIN(PW); SBAR(); }while(0)
  #define EX(v) __builtin_amdgcn_exp2f(v)
  #define GAPB(MF,X,B) do{ MF; X[B]=EX(X[B]); X[B+1]=EX(X[B+1]); X[B+2]=EX(X[B+2]); X[B+3]=EX(X[B+3]); PIN(X); SBAR(); }while(0)
  #define VRD(i) do{ vlo[i]=vtr(vp_+(((i)>>2)*4096+((i)&3)*1024)); vhi[i]=vtr(vp_+(((i)>>2)*4096+((i)&3)*1024+512)); }while(0)
  #define KRD(G,j) do{ if(G){ kload2(kf,kp0+sl_next,j); SBAR(); } }while(0)
  #define STEP(C0,C1,P0,P1,t,GK,GV,GL) do{ SBAR(); FSUB(C0,C1); SBAR(); \
    const lds_cptr vp_=vp0+sl_prev; \
    VRD(0); SBAR(); float sacc=(P0[0]+P0[1]); \
    GAPA(C0=__builtin_amdgcn_mfma_f32_32x32x16_bf16(kf[0],qr[0],C0,0,0,0), P0[2],P0[3],P0[4],P0[5],     pw0[0]=PKW(P0,0), pw0[1]=PKW(P0,2), pw0); \
    VRD(4); SBAR(); GAPA(C1=__builtin_amdgcn_mfma_f32_32x32x16_bf16(kf[1],qr[0],C1,0,0,0), P0[6],P0[7],P0[8],P0[9],     pw0[2]=PKW(P0,4), pw0[3]=PKW(P0,6), pw0); \
    VRD(1); SBAR(); GAPA(C0=__builtin_amdgcn_mfma_f32_32x32x16_bf16(kf[2],qr[1],C0,0,0,0),   P0[10],P0[11],P0[12],P0[13], pw1[0]=PKW(P0,8), pw1[1]=PKW(P0,10), pw1); \
    VRD(5); SBAR(); GAPA(C1=__builtin_amdgcn_mfma_f32_32x32x16_bf16(kf[3],qr[1],C1,0,0,0),   P0[14],P0[15],P1[0],P1[1],   pw1[2]=PKW(P0,12),pw1[3]=PKW(P0,14), pw1); \
    VRD(2); SBAR(); GAPA(C0=__builtin_amdgcn_mfma_f32_32x32x16_bf16(kf[4],qr[2],C0,0,0,0),   P1[2],P1[3],P1[4],P1[5],     pw2[0]=PKW(P1,0), pw2[1]=PKW(P1,2), pw2); \
    VRD(6); SBAR(); GAPA(C1=__builtin_amdgcn_mfma_f32_32x32x16_bf16(kf[5],qr[2],C1,0,0,0),   P1[6],P1[7],P1[8],P1[9],     pw2[2]=PKW(P1,4), pw2[3]=PKW(P1,6), pw2); \
    VRD(3); SBAR(); GAPA(C0=__builtin_amdgcn_mfma_f32_32x32x16_bf16(kf[6],qr[3],C0,0,0,0),   P1[10],P1[11],P1[12],P1[13], pw3[0]=PKW(P1,8), pw3[1]=PKW(P1,10), pw3); \
    VRD(7); SBAR(); GAPA(C1=__builtin_amdgcn_mfma_f32_32x32x16_bf16(kf[7],qr[3],C1,0,0,0),   P1[14],P1[15],0.f,0.f,       pw3[2]=PKW(P1,12),pw3[3]=PKW(P1,14), pw3); \
    l_reg+=sacc; \
    if(GK){DMA_K((t)+3,sl_cur);} if(GV){DMA_V((t)+1,sl_next);} \
    CMASK(C0,C1,t); \
    { float a=MX3(C0[0],C0[1],C1[0]),b=MX3(C0[2],C0[3],C1[1]); a=MX3(a,C1[2],C1[3]); \
      _Pragma("unroll") for(int r=4;r<16;r+=4){a=MX3(a,C0[r],C0[r+1]);b=MX3(b,C0[r+2],C0[r+3]);a=MX3(a,C1[r],C1[r+1]);b=MX3(b,C1[r+2],C1[r+3]);} \
      float rm=__builtin_fmaxf(a,b); { auto rr=__builtin_amdgcn_permlane32_swap(__float_as_uint(rm),__float_as_uint(rm),false,false); rm=__builtin_fmaxf(__uint_as_float(rr[0]),__uint_as_float(rr[1])); } \
      resc=false; \
      if(__builtin_expect(__any(rm>(float)THRL),0)){ const float dl=__builtin_fmaxf(rm,0.f); fref-=dl; \
        _Pragma("unroll") for(int r=0;r<16;++r){C0[r]-=dl;C1[r]-=dl;} \
        const float f=__builtin_amdgcn_exp2f(-dl); l_reg*=f; { int l2_; asm volatile("v_mbcnt_lo_u32_b32 %0, -1, 0\n\tv_mbcnt_hi_u32_b32 %0, -1, %0":"=v"(l2_)); if(l2_<32)wsf[l2_]=f; } resc=true; } } \
    SBAR(); \
    GAPB(o[0]=__builtin_amdgcn_mfma_f32_32x32x16_bf16(PAF(0),VFR(0),o[0],0,0,0), C0,0); \
    GAPB(o[1]=__builtin_amdgcn_mfma_f32_32x32x16_bf16(PAF(0),VFR(4),o[1],0,0,0), C0,4); \
    KRD(GL,0); GAPB(o[0]=__builtin_amdgcn_mfma_f32_32x32x16_bf16(PAF(1),VFR(1),o[0],0,0,0), C0,8); \
    KRD(GL,1); GAPB(o[1]=__builtin_amdgcn_mfma_f32_32x32x16_bf16(PAF(1),VFR(5),o[1],0,0,0), C0,12); \
    KRD(GL,2); GAPB(o[0]=__builtin_amdgcn_mfma_f32_32x32x16_bf16(PAF(2),VFR(2),o[0],0,0,0), C1,0); \
    KRD(GL,3); GAPB(o[1]=__builtin_amdgcn_mfma_f32_32x32x16_bf16(PAF(2),VFR(6),o[1],0,0,0), C1,4); \
    GAPB(o[0]=__builtin_amdgcn_mfma_f32_32x32x16_bf16(PAF(3),VFR(3),o[0],0,0,0), C1,8); \
    GAPB(o[1]=__builtin_amdgcn_mfma_f32_32x32x16_bf16(PAF(3),VFR(7),o[1],0,0,0), C1,12); \
    if(GL){ FLOAD(P0,P1,(t)+1); } \
    }while(0)
  int t=1;
  #undef CMASK
  #define CMASK(P0,P1,t) do{}while(0)
  for(;t+5<NT;t+=2){
    STEP(pB0,pB1,pA0,pA1,t,true,true,true);     WAIT_BAR(2); RESC(); ROT();
    STEP(pA0,pA1,pB0,pB1,t+1,true,true,true);   WAIT_BAR(2); RESC(); ROT();
  }
  #undef CMASK
  #define CMASK(P0,P1,t) do{int jb_=(t)-(NT-4); if(jb_>=0)cmask(P0,P1,jb_,qrel,hi);}while(0)
  #define ENDW(tt) do{ if((tt)+3<NT){WAIT_BAR(2);} else if((tt)+2<NT){WAIT_BAR(1);} else {WAIT_BAR(0);} }while(0)
  for(;t+1<NT;t+=2){
    STEP(pB0,pB1,pA0,pA1,t,(t+3<NT),(t+1<NT),(t+1<NT));       ENDW(t);   RESC(); ROT();
    STEP(pA0,pA1,pB0,pB1,t+1,(t+4<NT),(t+2<NT),(t+2<NT));     ENDW(t+1); RESC(); ROT();
  }
  STEP(pB0,pB1,pA0,pA1,NT-1,false,false,false); RESC();
  { float sacc=pB0[0]+pB0[1]; _Pragma("unroll") for(int r=2;r<16;++r)sacc+=pB0[r]; _Pragma("unroll") for(int r=0;r<16;++r)sacc+=pB1[r]; l_reg+=sacc;
    pw0=(u32x4){PKW(pB0,0),PKW(pB0,2),PKW(pB0,4),PKW(pB0,6)};pw1=(u32x4){PKW(pB0,8),PKW(pB0,10),PKW(pB0,12),PKW(pB0,14)};pw2=(u32x4){PKW(pB1,0),PKW(pB1,2),PKW(pB1,4),PKW(pB1,6)};pw3=(u32x4){PKW(pB1,8),PKW(pB1,10),PKW(pB1,12),PKW(pB1,14)};
    SBAR(); pv(o,vb0+sl_cur,PAF(0),PAF(1),PAF(2),PAF(3)); }
  #undef PKW
  #undef PAF
  #undef VFR
  #undef PIN
  #undef MX3
  #undef GAPA
  #undef GAPB
  #undef EX
  #undef VRD
  #undef KRD
  #undef STEP
  #undef ENDW
  {auto rr=__builtin_amdgcn_permlane32_swap(__float_as_uint(l_reg),__float_as_uint(l_reg),false,false);l_reg=__uint_as_float(rr[0])+__uint_as_float(rr[1]);}
  if(hi==0)wsf[32+r32]=l_reg;asm volatile("s_waitcnt lgkmcnt(0)":::"memory");
  float rli[16];
  #pragma unroll
  for(int r=0;r<16;++r)rli[r]=__builtin_amdgcn_rcpf(wsf[32+crow(r,hi)]);
  bf16*Ow=O+(long)(q0+wid*QBLK)*PO+h*D; const bf16*Gw=G+(long)(q0+wid*QBLK)*DM+h*D;
  { bf16*stg=(bf16*)(shm+LDS_OST)+wid*2048;
    #pragma unroll
    for(int r=0;r<16;++r){const int orow=crow(r,hi);
      #pragma unroll
      for(int d0=0;d0<2;++d0)stg[orow*64+d0*32+r32]=__float2bfloat16(o[d0][r]*rli[r]);}
    asm volatile("s_waitcnt lgkmcnt(0)":::"memory");
    #pragma unroll
    for(int i=0;i<4;++i){const int row=i*8+(lane>>3),ch=lane&7; u32x4 v=*(const u32x4*)(stg+row*64+ch*8); const u32x4 g=*(const u32x4*)(Gw+(long)row*DM+ch*8);
      _Pragma("unroll") for(int e=0;e<4;++e){ const float gl=__uint_as_float(g[e]<<16), gh=__uint_as_float(g[e]&0xffff0000u), vl=__uint_as_float(v[e]<<16), vh=__uint_as_float(v[e]&0xffff0000u);
        const float sl=gl*__builtin_amdgcn_rcpf(1.f+__expf(-gl)), sh=gh*__builtin_amdgcn_rcpf(1.f+__expf(-gh)); v[e]=cvtpk_s(vl*sl,vh*sh); }
      ATTN_STORE16(Ow+(long)row*PO+ch*8,v);} }
  asm volatile("s_waitcnt lgkmcnt(0)\n\ts_barrier":::"memory");
  #undef DMA_K
  #undef DMA_V
  #undef CMASK
  #undef START
  #undef RESC
  #undef ROT
  #undef FLOAD
  #undef FSUB
}
constexpr int ATTN_LDS_BYTES=LDS_BYTES;
#undef SBAR
#undef WAIT_BAR
}
namespace cg = cooperative_groups;
constexpr int NWAVES = 8, NTHR = 512;
constexpr int T = 16384, DMODEL = 2048, INCOLS = 8336, NPAD = 8448, DPLE = 256, RW = 1024, FX = 1024, NH = 16, HD = 64;
constexpr int M = T;
constexpr float RMS_EPS = 1e-6f, GN_EPS = 64e-5f, LOG2E = 1.4426950408889634f;
constexpr size_t MiB = 1u << 20;
constexpr size_t WS_CTL = 0, WS_WIN = 1 * MiB, WS_WOUT = 34 * MiB, WS_WGATE = 42 * MiB, WS_WPLE = 50 * MiB, WS_W2T = 51 * MiB, WS_A2T = 51 * MiB + 512 * 1024, WS_PB = 52 * MiB,
                 WS_F2 = 60 * MiB, WS_RK = 61 * MiB, WS_SSQ = 62 * MiB, WS_XN = 64 * MiB, WS_ZS = 128 * MiB, WS_ZA = 144 * MiB, WS_ZB = 240 * MiB, WS_KP = 400 * MiB, WS_RS = 432 * MiB, WS_VS = 464 * MiB, WS_END = 500 * MiB;
constexpr size_t WS_YR = WS_ZA, WS_MB = WS_ZB, WS_PLE = WS_ZA + 32 * MiB;
constexpr size_t OUT_W1A = 0, OUT_QA = 32 * MiB, OUT_BT = 64 * MiB, OUT_KT = 96 * MiB;
constexpr size_t WS_U0 = WS_KP, WS_Y0 = WS_RS, WS_DD = 496 * MiB;
constexpr int LDS_BYTES = 154624;
constexpr int MISC_OFF = 153600;
constexpr int NRWB = 64;
#define LAS __attribute__((address_space(3)))
typedef unsigned short bf16;
typedef unsigned v4u __attribute__((ext_vector_type(4)));
typedef unsigned v2u __attribute__((ext_vector_type(2)));
typedef float f32x4 __attribute__((ext_vector_type(4)));
typedef short bf16x8 __attribute__((ext_vector_type(8)));
#define LDS_WAIT() asm volatile("s_waitcnt lgkmcnt(0)" ::: "memory")
#define RLX_AGENT __ATOMIC_RELAXED, __HIP_MEMORY_SCOPE_AGENT
#define LDS_WAIT() asm volatile("s_waitcnt lgkmcnt(0)" ::: "memory")
#define XB_TMO      128
#define XB_XCNT(j)  (256  + 64 * (j))
#define XB_XSUB(j)  (1280 + 64 * (j))
#define XB_XGEN(j)  (2304 + 64 * (j))
#define XB_TOP      3328
#define XB_TOPGEN   3392
#define XCD_BAR_WORDS 3456
#define XB_SPIN_CAP (1u << 22)

__device__ __forceinline__ unsigned xb_ld(unsigned* p)              { return __hip_atomic_load(p, __ATOMIC_RELAXED, __HIP_MEMORY_SCOPE_AGENT); }
__device__ __forceinline__ unsigned xb_add(unsigned* p, unsigned v) { return __hip_atomic_fetch_add(p, v, __ATOMIC_RELAXED, __HIP_MEMORY_SCOPE_AGENT); }
__device__ __forceinline__ unsigned xb_xcc_id() { return (unsigned)__builtin_amdgcn_s_getreg((3 << 11) | 20) & 0xFu; }
#define XB_SPIN(cond, bar) do { unsigned _sp = 0; while (cond) { __builtin_amdgcn_s_sleep(1); \
    if ((++_sp & 255u) == 0u) { if (xb_ld(&(bar)[XB_TMO])) break; if (_sp > XB_SPIN_CAP) { atomicAdd(&(bar)[XB_TMO], 1u); break; } } } } while (0)

struct XcdBarrier {
    unsigned* bar; unsigned x;
    volatile LAS unsigned* st;
};

__device__ __forceinline__ XcdBarrier xcd_barrier_post(unsigned* bar, volatile LAS unsigned* st, int tid) {
    XcdBarrier b; b.bar = bar; b.x = xb_xcc_id(); b.st = st;
    if (tid == 0) (void)xb_add(&bar[XB_XCNT(b.x)], 1u);
    return b;
}
__device__ __forceinline__ void xcd_barrier_complete(unsigned* bar, unsigned x, unsigned& nloc, unsigned& nx) {
    const unsigned G = gridDim.x * gridDim.y * gridDim.z;
    unsigned sum, cnt, mine, sp = 0u;
    for (;;) {
        sum = 0u; cnt = 0u; mine = 0u;
#pragma unroll
        for (unsigned j = 0; j < 16; ++j) { const unsigned c = xb_ld(&bar[XB_XCNT(j)]); sum += c; cnt += (c > 0u) ? 1u : 0u; mine = (j == x) ? c : mine; }
        if (sum == G) break;
        __builtin_amdgcn_s_sleep(1);
        if ((++sp & 255u) == 0u) { if (xb_ld(&bar[XB_TMO])) break; if (sp > XB_SPIN_CAP) { atomicAdd(&bar[XB_TMO], 1u); break; } }
    }
    nloc = mine > 0u ? mine : 1u; nx = cnt > 0u ? cnt : 1u;
}

__device__ __forceinline__ void xcd_barrier(const XcdBarrier& b, int tid) {
    asm volatile("s_waitcnt vmcnt(0)" ::: "memory");
    __syncthreads();
    if (tid == 0) {
        unsigned* bar = b.bar;
        __builtin_amdgcn_s_waitcnt(0);
        unsigned nloc = b.st[0], nx = b.st[1];
        if (nloc == 0u) { xcd_barrier_complete(bar, b.x, nloc, nx); b.st[0] = nloc; b.st[1] = nx; }
        const unsigned old = xb_add(&bar[XB_XSUB(b.x)], 1u);
        const unsigned gen = old / nloc;
        if (old + 1u == (gen + 1u) * nloc) {
            __builtin_amdgcn_fence(__ATOMIC_RELEASE, "agent");
            asm volatile("s_waitcnt vmcnt(0)" ::: "memory");
            const unsigned og = xb_add(&bar[XB_TOP], 1u);
            const unsigned tg = og / nx;
            if (og + 1u == (tg + 1u) * nx) xb_add(&bar[XB_TOPGEN], 1u);
            else XB_SPIN(xb_ld(&bar[XB_TOPGEN]) == tg, bar);
            __builtin_amdgcn_fence(__ATOMIC_ACQUIRE, "agent");
            xb_add(&bar[XB_XGEN(b.x)], 1u);
            asm volatile("s_waitcnt vmcnt(0)" ::: "memory");
        } else {
            XB_SPIN(xb_ld(&bar[XB_XGEN(b.x)]) == gen, bar);
            __builtin_amdgcn_fence(__ATOMIC_ACQUIRE, "agent");
            asm volatile("s_waitcnt vmcnt(0)" ::: "memory");
        }
    }
    __syncthreads();
}
__device__ __forceinline__ unsigned f2bf(float f) { unsigned u = __builtin_bit_cast(unsigned, f); return (u + 0x7fffu + ((u >> 16) & 1u)) >> 16; }
typedef float f32x2_ __attribute__((ext_vector_type(2))); typedef __bf16 bf16x2_ __attribute__((ext_vector_type(2)));
__device__ __forceinline__ unsigned pk2(float lo, float hi) { f32x2_ v = {lo, hi}; return __builtin_bit_cast(unsigned, __builtin_convertvector(v, bf16x2_)); }
__device__ __forceinline__ float bflo(unsigned u) { return __uint_as_float(u << 16); }
__device__ __forceinline__ float bfhi(unsigned u) { return __uint_as_float(u & 0xffff0000u); }
__device__ __forceinline__ float wave_sum(float v) {
#pragma unroll
    for (int o = 1; o < 64; o <<= 1) v += __shfl_xor(v, o);
    return v;
}
__device__ __forceinline__ float dpp_add(float x, float y_src, int) { return x + y_src; }
__device__ __forceinline__ float row16_sum(float x) {
    x += __uint_as_float(__builtin_amdgcn_update_dpp(0, __float_as_uint(x), 0xB1, 0xf, 0xf, false));
    x += __uint_as_float(__builtin_amdgcn_update_dpp(0, __float_as_uint(x), 0x4E, 0xf, 0xf, false));
    x += __uint_as_float(__builtin_amdgcn_update_dpp(0, __float_as_uint(x), 0x141, 0xf, 0xf, false));
    x += __uint_as_float(__builtin_amdgcn_update_dpp(0, __float_as_uint(x), 0x140, 0xf, 0xf, false));
    return x;
}
__device__ __forceinline__ float quad_sum(float x) {
    x += __uint_as_float(__builtin_amdgcn_update_dpp(0, __float_as_uint(x), 0xB1, 0xf, 0xf, false));
    x += __uint_as_float(__builtin_amdgcn_update_dpp(0, __float_as_uint(x), 0x4E, 0xf, 0xf, false));
    return x;
}
struct Args { const float* in[26]; float* out; unsigned char* ws; };
__device__ __forceinline__ int lane_id() { int l__; asm volatile("v_mbcnt_lo_u32_b32 %0, -1, 0\n\tv_mbcnt_hi_u32_b32 %0, -1, %0" : "=v"(l__)); return l__; }
struct Frame {
    LAS unsigned char* lds; int wave, G, gw, NGW, lane, tid;
};
#define PHASE_BEGIN() do { int l_ = lane_id(); asm volatile("" : "+v"(l_)); F.lane = l_; F.tid = F.wave * 64 + l_; } while (0)

__device__ __forceinline__ void p0_transpose_item(const float* W, int K, int N, bf16* WT, int k0, int n0, int dst_row0, LAS float* scr, int lane) {
    const bool ok = (n0 + (lane & 31)) < N;
    float tv[32];
#pragma unroll
    for (int i = 0; i < 32; ++i) { const int kk = 2 * i + (lane >> 5); tv[i] = ok ? W[(size_t)(k0 + kk) * N + n0 + (lane & 31)] : 0.f; }
#pragma unroll
    for (int i = 0; i < 32; ++i) { const int kk = 2 * i + (lane >> 5); scr[kk * 33 + (lane & 31)] = tv[i]; }
    LDS_WAIT(); asm volatile("" ::: "memory");
    const int c = lane & 7;
#pragma unroll
    for (int j = 0; j < 4; ++j) { const int n = (lane >> 3) + 8 * j; const LAS float* s = scr + (8 * c) * 33 + n;
        v4u o; o.x = pk2(s[0 * 33], s[1 * 33]); o.y = pk2(s[2 * 33], s[3 * 33]); o.z = pk2(s[4 * 33], s[5 * 33]); o.w = pk2(s[6 * 33], s[7 * 33]);
        *(v4u*)(WT + (size_t)(dst_row0 + n) * K + k0 + 8 * c) = o; }
    LDS_WAIT(); asm volatile("" ::: "memory");
}
__device__ __forceinline__ int win_map(int c) {
    if (c < 3072) return c;
    if (c < 4096) return c - 3072 + 7168;
    if (c < 4160) return c - 4096 + 8192;
    if (c < 4224) return c - 4160 + 8256;
    if (c < 8320) return c - 4224 + 3072;
    return c - 8320 + 8320;
}
__device__ __forceinline__ void rms_row_to_bf16(const float* xrow, const float* g, bf16* orow, int lane) {
    const f32x4* xr = (const f32x4*)xrow + lane; const f32x4* gr = (const f32x4*)g + lane;
    f32x4 v[8]; float s = 0.f;
#pragma unroll
    for (int j = 0; j < 8; ++j) { v[j] = xr[64 * j]; s += (v[j].x * v[j].x + v[j].y * v[j].y) + (v[j].z * v[j].z + v[j].w * v[j].w); }
    const float rstd = 1.f / sqrtf(wave_sum(s) * (1.f / DMODEL) + RMS_EPS);
    v2u* o8 = (v2u*)orow + lane;
#pragma unroll
    for (int j = 0; j < 8; ++j) { const f32x4 gg = gr[64 * j]; v2u o; o.x = pk2(v[j].x * rstd * gg.x, v[j].y * rstd * gg.y); o.y = pk2(v[j].z * rstd * gg.z, v[j].w * rstd * gg.w); o8[64 * j] = o; }
}

__device__ __forceinline__ void rms_row2_to_bf16(const float* x0, const float* x1, const float* g, bf16* o0, bf16* o1, int lane) {
    const f32x4* xr0 = (const f32x4*)x0 + lane; const f32x4* xr1 = (const f32x4*)x1 + lane; const f32x4* gr = (const f32x4*)g + lane;
    f32x4 v[8], w[8]; float s = 0.f, t = 0.f;
#pragma unroll
    for (int j = 0; j < 8; ++j) { v[j] = xr0[64 * j]; w[j] = xr1[64 * j]; }
#pragma unroll
    for (int j = 0; j < 8; ++j) { s += (v[j].x * v[j].x + v[j].y * v[j].y) + (v[j].z * v[j].z + v[j].w * v[j].w); t += (w[j].x * w[j].x + w[j].y * w[j].y) + (w[j].z * w[j].z + w[j].w * w[j].w); }
#pragma unroll
    for (int o = 1; o < 64; o <<= 1) { s += __shfl_xor(s, o); t += __shfl_xor(t, o); }
    const float r0 = 1.f / sqrtf(s * (1.f / DMODEL) + RMS_EPS), r1 = 1.f / sqrtf(t * (1.f / DMODEL) + RMS_EPS);
    v2u* p0 = (v2u*)o0 + lane; v2u* p1 = (v2u*)o1 + lane;
#pragma unroll
    for (int j = 0; j < 8; ++j) { const f32x4 gg = gr[64 * j]; const f32x4 a0 = v[j] * r0 * gg, a1 = w[j] * r1 * gg; v2u q0, q1; q0.x = pk2(a0.x, a0.y); q0.y = pk2(a0.z, a0.w); q1.x = pk2(a1.x, a1.y); q1.y = pk2(a1.z, a1.w); p0[64 * j] = q0; p1[64 * j] = q1; }
}
__device__ __forceinline__ void p0_prologue(Frame& F, const Args& a) {
    unsigned char* ws = a.ws;
    LAS float* scr = (LAS float*)(F.lds + F.wave * 16384);
    bf16* Wt_in = (bf16*)(ws + WS_WIN); bf16* Wt_out = (bf16*)(ws + WS_WOUT); bf16* Wt_gate = (bf16*)(ws + WS_WGATE); bf16* Wt_ple = (bf16*)(ws + WS_WPLE); bf16* W2t = (bf16*)(ws + WS_W2T); bf16* A2t = (bf16*)(ws + WS_A2T);
    constexpr int NB_IN = (INCOLS + 31) / 32;
    constexpr int I_IN = (DMODEL / 64) * NB_IN, I_SQ = (DMODEL / 64) * (DMODEL / 32), I_PLE = (DPLE / 64) * (DMODEL / 32), I_LORA = (64 / 64) * (RW / 32);
    constexpr int NITEMS = I_IN + 2 * I_SQ + I_PLE + 2 * I_LORA;
    for (int it = F.gw; it < NITEMS; it += F.NGW) {
        int r = it;
        if (r < I_IN) { const int kb = r / NB_IN, nb = r % NB_IN; p0_transpose_item(a.in[3], DMODEL, INCOLS, Wt_in, 64 * kb, 32 * nb, win_map(32 * nb), scr, F.lane); continue; } r -= I_IN;
        if (r < I_SQ) { const int kb = r / 64, nb = r % 64; p0_transpose_item(a.in[21], DMODEL, DMODEL, Wt_out, 64 * kb, 32 * nb, 32 * nb, scr, F.lane); continue; } r -= I_SQ;
        if (r < I_SQ) { const int kb = r / 64, nb = r % 64; p0_transpose_item(a.in[24], DMODEL, DMODEL, Wt_gate, 64 * kb, 32 * nb, 32 * nb, scr, F.lane); continue; } r -= I_SQ;
        if (r < I_PLE) { const int kb = r / 64, nb = r % 64; p0_transpose_item(a.in[25], DPLE, DMODEL, Wt_ple, 64 * kb, 32 * nb, 32 * nb, scr, F.lane); continue; } r -= I_PLE;
        if (r < I_LORA) { p0_transpose_item(a.in[10], 64, RW, W2t, 0, 32 * r, 32 * r, scr, F.lane); continue; } r -= I_LORA;
        p0_transpose_item(a.in[12], 64, RW, A2t, 0, 32 * r, 32 * r, scr, F.lane);
    }
    { v4u* z = (v4u*)(Wt_in + (size_t)8352 * DMODEL); const int n16 = (NPAD - 8352) * DMODEL * 2 / 16; const v4u zero = {0u, 0u, 0u, 0u};
      for (int i = F.gw * 64 + F.lane; i < n16; i += F.NGW * 64) z[i] = zero; }
    bf16* XN = (bf16*)(ws + WS_XN);
    for (int m = F.gw; m < M; m += 2 * F.NGW) rms_row2_to_bf16(a.in[0] + (size_t)m * DMODEL, a.in[0] + (size_t)(m + F.NGW) * DMODEL, a.in[2], XN + (size_t)m * DMODEL, XN + (size_t)(m + F.NGW) * DMODEL, F.lane);
    { const f32x4* p4 = (const f32x4*)a.in[1]; v4u* o = (v4u*)(ws + WS_PB); const int n8 = M * DPLE / 8;
      for (int i = F.gw * 64 + F.lane; i < n8; i += F.NGW * 64) { const f32x4 u0 = p4[2 * i], u1 = p4[2 * i + 1]; v4u w; w.x = pk2(u0.x, u0.y); w.y = pk2(u0.z, u0.w); w.z = pk2(u1.x, u1.y); w.w = pk2(u1.z, u1.w); o[i] = w; } }
}

__device__ __forceinline__ float log_sigmoid(float x) { return fminf(x, 0.f) - log1pf(expf(-fabsf(x))); }
__device__ __forceinline__ void p2a_fgroup(Frame& F, const Args& a, int g) {
    const float* ZS = (const float*)(a.ws + WS_ZS); float* F2 = (float*)(a.ws + WS_F2); float* PS = (float*)(a.ws + WS_SSQ);
    LAS float* sc = (LAS float*)F.lds;
    const int h = F.tid & 15, r0 = F.tid >> 4; const float bf = a.in[18][h];
#pragma unroll
    for (int k = 0; k < 2; ++k) { const int r = r0 + 32 * k; sc[r * 16 + h] = log_sigmoid(ZS[(size_t)(g * 64 + r) * 256 + 128 + h] + bf) * LOG2E; }
    __syncthreads();
    if (F.tid < 16) { float run = 0.f; for (int r = 0; r < 64; ++r) { run += sc[r * 16 + F.tid]; sc[r * 16 + F.tid] = run; } PS[g * 16 + F.tid] = run; }
    __syncthreads();
#pragma unroll
    for (int k = 0; k < 2; ++k) { const int r = r0 + 32 * k; F2[(size_t)h * T + g * 64 + r] = sc[r * 16 + h]; }
    __syncthreads();
}
__device__ __forceinline__ void p2b_fgroup(Frame& F, const Args& a, int g) {
    float* F2 = (float*)(a.ws + WS_F2); const float* PS = (const float*)(a.ws + WS_SSQ);
    LAS float* sc = (LAS float*)F.lds;
    const int h = F.tid & 15, part = F.tid >> 4; float s = 0.f;
    for (int gg = part; gg < g; gg += 32) s += PS[gg * 16 + h];
    sc[part * 16 + h] = s; __syncthreads();
    if (F.tid < 16) { float o = 0.f; for (int p = 0; p < 32; ++p) o += sc[p * 16 + F.tid]; sc[512 + F.tid] = o; }
    __syncthreads();
    const float off = sc[512 + h];
#pragma unroll
    for (int k = 0; k < 2; ++k) { const int r = part + 32 * k; F2[(size_t)h * T + g * 64 + r] += off; }
    __syncthreads();
}
__device__ __forceinline__ void p2_qknorm_row(const Args& a, int row, int lane) {
    bf16* zb = (bf16*)(a.ws + WS_ZB) + (size_t)row * 5120;
#pragma unroll
    for (int part = 0; part < 2; ++part) {
        v4u* p = (v4u*)(zb + part * 1024 + lane * 16); const v4u u0 = p[0], u1 = p[1];
        float x[16];
#pragma unroll
        for (int e = 0; e < 4; ++e) { x[2 * e] = bflo(u0[e]); x[2 * e + 1] = bfhi(u0[e]); x[8 + 2 * e] = bflo(u1[e]); x[8 + 2 * e + 1] = bfhi(u1[e]); }
        float ss = 0.f;
#pragma unroll
        for (int e = 0; e < 16; ++e) ss += x[e] * x[e];
        ss = quad_sum(ss);
        const float rstd = (1.f / sqrtf(ss * (1.f / 64.f) + RMS_EPS)) * (part == 0 ? attn_body::C2 : 1.f);
        const f32x4* g4 = (const f32x4*)(a.in[part == 0 ? 19 : 20] + (lane & 3) * 16);
        v4u o0, o1;
#pragma unroll
        for (int e = 0; e < 2; ++e) { const f32x4 ga = g4[e], gb = g4[2 + e];
            o0[2 * e] = pk2(x[4 * e] * rstd * ga.x, x[4 * e + 1] * rstd * ga.y); o0[2 * e + 1] = pk2(x[4 * e + 2] * rstd * ga.z, x[4 * e + 3] * rstd * ga.w);
            o1[2 * e] = pk2(x[8 + 4 * e] * rstd * gb.x, x[8 + 4 * e + 1] * rstd * gb.y); o1[2 * e + 1] = pk2(x[8 + 4 * e + 2] * rstd * gb.z, x[8 + 4 * e + 3] * rstd * gb.w); }
        p[0] = o0; p[1] = o1;
    }
}
__device__ __forceinline__ f32x4 ld4(const float* p) { return *(const f32x4*)p; }
__device__ __forceinline__ f32x4 bf4(v2u u) { return (f32x4){bflo(u.x), bfhi(u.x), bflo(u.y), bfhi(u.y)}; }
__device__ __forceinline__ v2u pk4(f32x4 v) { v2u o; o.x = pk2(v.x, v.y); o.y = pk2(v.z, v.w); return o; }
__device__ __forceinline__ float fast_tanh(float x) { x = fminf(fmaxf(x, -15.f), 15.f); const float e = __expf(2.f * x); return (e - 1.f) / (e + 1.f); }
typedef short bf16x4s __attribute__((ext_vector_type(4)));
__device__ __forceinline__ bf16x4s pk4s(f32x4 v) { return __builtin_bit_cast(bf16x4s, pk4(v)); }
__device__ __forceinline__ bf16x8 pk8s(f32x4 a, f32x4 b) { v4u u; u.x = pk2(a.x, a.y); u.y = pk2(a.z, a.w); u.z = pk2(b.x, b.y); u.w = pk2(b.z, b.w); return __builtin_bit_cast(bf16x8, u); }
#define MFMA16(a, b, c) __builtin_amdgcn_mfma_f32_16x16x16bf16_1k(a, b, c, 0, 0, 0)
#define MFMA32(a, b, c) __builtin_amdgcn_mfma_f32_16x16x32_bf16(a, b, c, 0, 0, 0)
__device__ __forceinline__ f32x4 exp4(f32x4 x) { return (f32x4){__expf(x.x), __expf(x.y), __expf(x.z), __expf(x.w)}; }
__device__ __forceinline__ f32x4 shfl4(f32x4 v, int src) { return (f32x4){__shfl(v.x, src), __shfl(v.y, src), __shfl(v.z, src), __shfl(v.w, src)}; }
__device__ __forceinline__ void rw_chunk_prep(const Args& a, int head, int tc0, const LAS bf16* TDr, const LAS bf16* DAr, LAS unsigned char* lw_, int lane) {
    unsigned char* ws = a.ws;
    const bf16* ZA = (const bf16*)(ws + WS_ZA);
    const int j = lane & 15, rg = lane >> 4, kg = rg, cbase = head * 64 + 4 * j;
    const bf16* W2t = (const bf16*)(ws + WS_W2T); const bf16* A2t = (const bf16*)(ws + WS_A2T);
    f32x4 accw[4], acca[4];
    {   bf16x8 atd[2], ada[2];
#pragma unroll
        for (int kk = 0; kk < 2; ++kk) { atd[kk] = *(const LAS bf16x8*)(TDr + j * 64 + kk * 32 + kg * 8); ada[kk] = *(const LAS bf16x8*)(DAr + j * 64 + kk * 32 + kg * 8); }
#pragma unroll
        for (int cb = 0; cb < 4; ++cb) { accw[cb] = (f32x4){0.f, 0.f, 0.f, 0.f}; acca[cb] = (f32x4){0.f, 0.f, 0.f, 0.f};
#pragma unroll
            for (int kk = 0; kk < 2; ++kk) { const bf16x8 bw = *(const bf16x8*)(W2t + (size_t)(cbase + cb) * 64 + kk * 32 + kg * 8), ba = *(const bf16x8*)(A2t + (size_t)(cbase + cb) * 64 + kk * 32 + kg * 8);
                accw[cb] = MFMA32(atd[kk], bw, accw[cb]); acca[cb] = MFMA32(ada[kk], ba, acca[cb]); } }
    }
    const f32x4 w0 = ld4(a.in[9] + cbase), a0 = ld4(a.in[11] + cbase), kkw = ld4(a.in[13] + cbase), kaw = ld4(a.in[14] + cbase), rkw = ld4(a.in[15] + cbase);
    const f32x4 mur = ld4(a.in[4] + cbase), muk = ld4(a.in[5] + cbase), muv = ld4(a.in[6] + cbase);
    float* RK = (float*)(ws + WS_RK);
    f32x4 rr[4], km[4], av[4], bv[4], lw[4], vv[4];
    {   const int tt0 = tc0 + 4 * rg; const f32x4 zero = {0.f, 0.f, 0.f, 0.f};
        f32x4 pr = tt0 > 0 ? bf4(*(const v2u*)(ZA + (size_t)(tt0 - 1) * 3072 + cbase)) : zero;
        f32x4 pk = tt0 > 0 ? bf4(*(const v2u*)(ZA + (size_t)(tt0 - 1) * 3072 + 1024 + cbase)) : zero;
        f32x4 pv = tt0 > 0 ? bf4(*(const v2u*)(ZA + (size_t)(tt0 - 1) * 3072 + 2048 + cbase)) : zero;
#pragma unroll
        for (int i = 0; i < 4; ++i) {
            const int tt = tt0 + i;
            const f32x4 zr = bf4(*(const v2u*)(ZA + (size_t)tt * 3072 + cbase)), zk = bf4(*(const v2u*)(ZA + (size_t)tt * 3072 + 1024 + cbase)), zv = bf4(*(const v2u*)(ZA + (size_t)tt * 3072 + 2048 + cbase));
            const f32x4 r = zr + (pr - zr) * mur, k = zk + (pk - zk) * muk, v = zv + (pv - zv) * muv;
            pr = zr; pk = zk; pv = zv;
            f32x4 lwv, alr;
#pragma unroll
            for (int cb = 0; cb < 4; ++cb) { const float x = -(w0[cb] + accw[cb][i]); const float sp = fmaxf(x, 0.f) + __logf(1.f + __expf(-fabsf(x))); lwv[cb] = -__expf(-sp - 0.5f); alr[cb] = __builtin_amdgcn_rcpf(1.f + __expf(-(a0[cb] + acca[cb][i]))); }
            const f32x4 kkr = k * kkw, kmod = k * (1.f + (alr - 1.f) * kaw);
            float ssq = (kkr.x * kkr.x + kkr.y * kkr.y) + (kkr.z * kkr.z + kkr.w * kkr.w);
            const f32x4 rkk = r * kmod * rkw; float rkp = (rkk.x + rkk.y) + (rkk.z + rkk.w);
            ssq = row16_sum(ssq); rkp = row16_sum(rkp);
            const float inv = __builtin_amdgcn_rsqf(fmaxf(ssq, 1e-24f));
            const f32x4 kk = kkr * inv;
            rr[i] = r; km[i] = kmod; av[i] = -kk; bv[i] = kk * alr; lw[i] = lwv; vv[i] = v;
            if (j == 0) RK[(size_t)tt * 16 + head] = rkp;
        }
    }
    f32x4 lci[4], ltot;
    {   lci[0] = lw[0]; lci[1] = lci[0] + lw[1]; lci[2] = lci[1] + lw[2]; lci[3] = lci[2] + lw[3];
        f32x4 s = lci[3];
        const f32x4 t1 = shfl4(s, lane - 16); if (rg >= 1) s = s + t1;
        const f32x4 t2 = shfl4(s, lane - 32); if (rg >= 2) s = s + t2;
        const f32x4 excl = s - lci[3];
        ltot = shfl4(s, 48 + j);
#pragma unroll
        for (int i = 0; i < 4; ++i) lci[i] = lci[i] + excl;
    }
    LAS bf16* TA = (LAS bf16*)lw_; LAS bf16* TR = TA + 1024; LAS bf16* TB = TR + 1024; LAS bf16* TK = TB + 1024; LAS float* MA = (LAS float*)(lw_ + 8192); LAS float* MT = MA + 256;
    f32x4 atT[4], rtT[4], bhT[4], khT[4], vT[4];
    {   f32x4 at[4], rt[4], bh[4], kh[4];
#pragma unroll
        for (int i = 0; i < 4; ++i) { const f32x4 ei = exp4(lci[i]), eo = exp4(-lci[i]), ee = exp4(lci[i] - lw[i]), eh = exp4(ltot - lci[i]);
            at[i] = av[i] * ee; rt[i] = rr[i] * ei; bh[i] = bv[i] * eh; kh[i] = km[i] * eh;
            const int row = 4 * rg + i;
            *(LAS v2u*)(TA + row * 64 + 4 * j) = pk4(at[i]); *(LAS v2u*)(TR + row * 64 + 4 * j) = pk4(rt[i]); *(LAS v2u*)(TB + row * 64 + 4 * j) = pk4(bv[i] * eo); *(LAS v2u*)(TK + row * 64 + 4 * j) = pk4(km[i] * eo); }
#pragma unroll
        for (int cb = 0; cb < 4; ++cb) { atT[cb] = (f32x4){at[0][cb], at[1][cb], at[2][cb], at[3][cb]}; rtT[cb] = (f32x4){rt[0][cb], rt[1][cb], rt[2][cb], rt[3][cb]};
            bhT[cb] = (f32x4){bh[0][cb], bh[1][cb], bh[2][cb], bh[3][cb]}; khT[cb] = (f32x4){kh[0][cb], kh[1][cb], kh[2][cb], kh[3][cb]}; vT[cb] = (f32x4){vv[0][cb], vv[1][cb], vv[2][cb], vv[3][cb]}; }
    }
    LDS_WAIT(); asm volatile("" ::: "memory");
    f32x4 AabT = {0.f, 0.f, 0.f, 0.f}, AakT = AabT, ArbT = AabT, ArkT = AabT;
#pragma unroll
    for (int kk = 0; kk < 2; ++kk) { const int o = j * 64 + kk * 32 + kg * 8;
        const bf16x8 pa = *(const LAS bf16x8*)(TA + o), pr = *(const LAS bf16x8*)(TR + o), pb = *(const LAS bf16x8*)(TB + o), pk = *(const LAS bf16x8*)(TK + o);
        AabT = MFMA32(pb, pa, AabT); AakT = MFMA32(pk, pa, AakT); ArbT = MFMA32(pb, pr, ArbT); ArkT = MFMA32(pk, pr, ArkT); }
#pragma unroll
    for (int e = 0; e < 4; ++e) { const int jp = 4 * rg + e; if (!(jp < j)) { AabT[e] = 0.f; AakT[e] = 0.f; } if (!(jp <= j)) { ArbT[e] = 0.f; ArkT[e] = 0.f; } }
    *(LAS f32x4*)(MA + j * 16 + 4 * rg) = AabT;
    LDS_WAIT(); asm volatile("" ::: "memory");
    {   float x[16];
#pragma unroll
        for (int t = 0; t < 16; ++t) { float s = (t == j) ? 1.f : 0.f;
#pragma unroll
            for (int q = 0; q < 4; ++q) { if (4 * q < t) { const f32x4 row = *(const LAS f32x4*)(MA + t * 16 + 4 * q);
#pragma unroll
                for (int e = 0; e < 4; ++e) if (4 * q + e < t) s += row[e] * x[4 * q + e]; } }
            x[t] = s; }
        if (rg == 0) {
#pragma unroll
            for (int t = 0; t < 16; ++t) MT[t * 16 + j] = x[t]; }
    }
    LDS_WAIT(); asm volatile("" ::: "memory");
    const bf16x4s TmA = pk4s(*(const LAS f32x4*)(MT + j * 16 + 4 * kg));
    const f32x4 z4 = {0.f, 0.f, 0.f, 0.f};
    const bf16x4s aak = pk4s(AakT), arb = pk4s(ArbT), ark = pk4s(ArkT);
    bf16x4s idb; { v2u u; u.x = ((4 * kg + 0 == j) ? 0x3F80u : 0u) | ((4 * kg + 1 == j) ? 0x3F800000u : 0u); u.y = ((4 * kg + 2 == j) ? 0x3F80u : 0u) | ((4 * kg + 3 == j) ? 0x3F800000u : 0u); idb = __builtin_bit_cast(bf16x4s, u); }
    const size_t ch = (size_t)(tc0 >> 4) * 16 + head;
    unsigned char* outb = (unsigned char*)a.out;
    f32x4 W1T[4], QT[4];
#pragma unroll
    for (int cb = 0; cb < 4; ++cb) {
        const bf16x4s atp = pk4s(atT[cb]), vtp = pk4s(vT[cb]);
        const f32x4 W1 = MFMA16(TmA, atp, z4);
        W1T[cb] = MFMA16(atp, TmA, z4);
        const f32x4 X = MFMA16(aak, vtp, z4);
        const f32x4 U0 = MFMA16(TmA, pk4s(X), z4);
        f32x4 q = MFMA16(pk4s(rtT[cb]), idb, z4);
        QT[cb] = MFMA16(pk4s(W1), arb, q);
        f32x4 y0 = MFMA16(arb, pk4s(U0), z4); y0 = MFMA16(ark, vtp, y0);
        *(v2u*)(ws + WS_U0 + ch * 2048 + cb * 512 + lane * 8) = pk4(U0);
        *(v2u*)(ws + WS_Y0 + ch * 2048 + cb * 512 + lane * 8) = pk4(y0);
        *(v2u*)(outb + OUT_BT + ch * 2048 + cb * 512 + lane * 8) = pk4(bhT[cb]);
        *(v2u*)(outb + OUT_KT + ch * 2048 + cb * 512 + lane * 8) = pk4(khT[cb]);
        *(v2u*)(ws + WS_VS + ch * 2048 + cb * 512 + lane * 8) = pk4(vT[cb]);
    }
#pragma unroll
    for (int kk = 0; kk < 2; ++kk) { *(bf16x8*)(outb + OUT_W1A + ch * 2048 + kk * 1024 + lane * 16) = pk8s(W1T[2 * kk], W1T[2 * kk + 1]); *(bf16x8*)(outb + OUT_QA + ch * 2048 + kk * 1024 + lane * 16) = pk8s(QT[2 * kk], QT[2 * kk + 1]); }
    if (rg == 0) { float* dd = (float*)(ws + WS_DD) + ch * 64; const f32x4 dv = exp4(ltot);
#pragma unroll
        for (int cb = 0; cb < 4; ++cb) dd[((j >> 2) * 4 + cb) * 4 + (j & 3)] = dv[cb]; }
    LDS_WAIT(); asm volatile("" ::: "memory");
}
__device__ __forceinline__ void p2_rwprep_tile(Frame& F, const Args& a, int t0) {
    unsigned char* ws = a.ws;
    const float* ZS = (const float*)(ws + WS_ZS);
    LAS bf16* TD = (LAS bf16*)F.lds; LAS bf16* DA = TD + 32 * 64;
    {
        const int tok = F.tid >> 4, c4 = (F.tid & 15) * 4, t = t0 + tok;
        const f32x4 zero = {0.f, 0.f, 0.f, 0.f};
        const f32x4 cw = ld4(ZS + (size_t)t * 256 + c4), ca = ld4(ZS + (size_t)t * 256 + 64 + c4);
        const f32x4 pw = t > 0 ? ld4(ZS + (size_t)(t - 1) * 256 + c4) : zero, pa = t > 0 ? ld4(ZS + (size_t)(t - 1) * 256 + 64 + c4) : zero;
        const f32x4 mw = ld4(a.in[7] + c4), ma = ld4(a.in[8] + c4);
        f32x4 dw = cw + (pw - cw) * mw, da = ca + (pa - ca) * ma;
        dw.x = fast_tanh(dw.x); dw.y = fast_tanh(dw.y); dw.z = fast_tanh(dw.z); dw.w = fast_tanh(dw.w);
        *(LAS v2u*)(TD + tok * 64 + c4) = pk4(dw); *(LAS v2u*)(DA + tok * 64 + c4) = pk4(da);
    }
    __syncthreads();
    LAS unsigned char* lw_ = F.lds + 8192 + F.wave * 10240;
    for (int q = 0; q < 4; ++q) { const int hh = q >> 1, rb = q & 1; rw_chunk_prep(a, 2 * F.wave + hh, t0 + rb * 16, TD + rb * 16 * 64, DA + rb * 16 * 64, lw_, F.lane); }
    __syncthreads();
}

struct ChunkOps { bf16x8 w1[2], qa[2]; bf16x4s bt[4], kt[4]; v2u u0, y0, vb; f32x4 d[4]; };
constexpr int SP_R = 15, SP_D = 12, SP_SLOT = 10240;
__device__ __forceinline__ void rw_slot_read(ChunkOps& C, const LAS unsigned char* s, int ib, int lane) {
    const int rg = lane >> 4;
#pragma unroll
    for (int kk = 0; kk < 2; ++kk) { C.w1[kk] = *(const LAS bf16x8*)(s + kk * 1024 + lane * 16); C.qa[kk] = *(const LAS bf16x8*)(s + 2048 + kk * 1024 + lane * 16); }
#pragma unroll
    for (int t = 0; t < 4; ++t) { C.bt[t] = *(const LAS bf16x4s*)(s + 4096 + t * 512 + lane * 8); C.kt[t] = *(const LAS bf16x4s*)(s + 6144 + t * 512 + lane * 8); C.d[t] = *(const LAS f32x4*)(s + 9728 + (rg * 4 + t) * 16); }
    C.u0 = *(const LAS v2u*)(s + 8192 + lane * 8); C.y0 = *(const LAS v2u*)(s + 8704 + lane * 8);
    C.vb = *(const LAS v2u*)(s + 9216 + lane * 8);
}
struct DmaPtrs { const unsigned char* p[4]; unsigned off[4]; };
__device__ __forceinline__ void rw_dma_init(const Args& a, DmaPtrs& P, int head, int ib, int lw, int lane) {
    const unsigned char* outb = (const unsigned char*)a.out; const unsigned char* ws = a.ws; const size_t c0 = (size_t)head * 2048;
    if (lw == 0) { P.p[0] = outb + OUT_W1A + c0 + lane * 16; P.p[1] = P.p[0] + 1024; P.p[2] = outb + OUT_QA + c0 + lane * 16; P.p[3] = P.p[2] + 1024; P.off[0] = 0u; P.off[1] = 1024u; P.off[2] = 2048u; P.off[3] = 3072u; }
    else if (lw == 1) { P.p[0] = outb + OUT_BT + c0 + lane * 16; P.p[1] = P.p[0] + 1024; P.p[2] = outb + OUT_KT + c0 + lane * 16; P.p[3] = P.p[2] + 1024; P.off[0] = 4096u; P.off[1] = 5120u; P.off[2] = 6144u; P.off[3] = 7168u; }
    else { const int l32 = lane & 31; P.p[0] = ws + WS_U0 + c0 + ib * 512 + l32 * 16; P.p[1] = ws + WS_Y0 + c0 + ib * 512 + l32 * 16; P.p[2] = ws + WS_VS + c0 + ib * 512 + l32 * 16; P.p[3] = ws + WS_DD + (size_t)head * 256 + (lane & 15) * 16;
           P.off[0] = 8192u; P.off[1] = 8704u; P.off[2] = 9216u; P.off[3] = 9728u; }
}
__device__ __forceinline__ void rw_dma_issue(DmaPtrs& P, int lw, int lane, unsigned slot_lds) {
    if (lw < 2) {
#pragma unroll
        for (int q = 0; q < 4; ++q) attn_body::glds16(P.p[q], (unsigned)__builtin_amdgcn_readfirstlane(slot_lds + P.off[q]));
    } else {
        if (lane < 32) {
#pragma unroll
            for (int q = 0; q < 3; ++q) attn_body::glds16(P.p[q], (unsigned)__builtin_amdgcn_readfirstlane(slot_lds + P.off[q])); }
        if (lane < 16) attn_body::glds16(P.p[3], (unsigned)__builtin_amdgcn_readfirstlane(slot_lds + P.off[3]));
    }
#pragma unroll
    for (int q = 0; q < 4; ++q) P.p[q] += (lw == 2 && q == 3) ? 16 * 256 : 16 * 2048;
}
__device__ __forceinline__ void p3_rwkv_state(Frame& F, const Args& a) {
    constexpr int NC = T / 16;
    const int xcd_ = blockIdx.x & 7, sl_ = blockIdx.x >> 3, head = 2 * xcd_ + (sl_ >> 2), ib = sl_ & 3, lane = F.lane, rg = lane >> 4;
    const unsigned lds0 = (unsigned)(uintptr_t)F.lds;
    const bool loader = F.wave >= 1 && F.wave <= 3; const int lw = F.wave - 1;
#define SP_BAR() asm volatile("s_waitcnt lgkmcnt(0)\n\ts_barrier" ::: "memory")
#define SP_WAIT() asm volatile("s_waitcnt vmcnt(36)" ::: "memory")
    if (loader) {
        DmaPtrs P; rw_dma_init(a, P, head, ib, lw, lane);
        for (int n = 0; n < SP_D; ++n) rw_dma_issue(P, lw, lane, lds0 + (unsigned)(n % SP_R) * SP_SLOT);
        SP_WAIT();
        SP_BAR();
        for (int n = 0; n < NC; n += 2) {
            if (n + SP_D + 1 < NC) { rw_dma_issue(P, lw, lane, lds0 + (unsigned)((n + SP_D) % SP_R) * SP_SLOT); rw_dma_issue(P, lw, lane, lds0 + (unsigned)((n + SP_D + 1) % SP_R) * SP_SLOT); SP_WAIT(); }
            else asm volatile("s_waitcnt vmcnt(0)" ::: "memory");
            SP_BAR();
        }
    } else if (F.wave == 0) {
        bf16* YR = (bf16*)(a.ws + WS_YR) + head * 64 + 4 * (lane & 15) + ib;
        f32x4 H[4]; bf16x8 Hb[2];
#pragma unroll
        for (int t = 0; t < 4; ++t) H[t] = (f32x4){0.f, 0.f, 0.f, 0.f};
        Hb[0] = pk8s(H[0], H[1]); Hb[1] = pk8s(H[2], H[3]);
        ChunkOps C, N;
        SP_BAR();
        rw_slot_read(C, F.lds, ib, lane);
#define SP_STEP(CC, NN, n_) do { { const int nn = ((n_) + 1 < NC) ? (n_) + 1 : (n_); rw_slot_read(NN, F.lds + (nn % SP_R) * SP_SLOT, ib, lane); } \
            const bf16x4s Vb = __builtin_bit_cast(bf16x4s, CC.vb); \
            f32x4 U = MFMA32(CC.w1[0], Hb[0], bf4(CC.u0)); U = MFMA32(CC.w1[1], Hb[1], U); \
            f32x4 hk[4]; _Pragma("unroll") for (int t = 0; t < 4; ++t) hk[t] = MFMA16(CC.kt[t], Vb, H[t] * CC.d[t]); \
            f32x4 Y = MFMA32(CC.qa[0], Hb[0], bf4(CC.y0)); Y = MFMA32(CC.qa[1], Hb[1], Y); \
            const bf16x4s Ub = pk4s(U); \
            _Pragma("unroll") for (int t = 0; t < 4; ++t) H[t] = MFMA16(CC.bt[t], Ub, hk[t]); \
            Hb[0] = pk8s(H[0], H[1]); Hb[1] = pk8s(H[2], H[3]); \
            { const unsigned y01 = pk2(Y[0], Y[1]), y23 = pk2(Y[2], Y[3]); bf16* yp_ = YR + (size_t)(16 * (n_) + 4 * rg) * 1024; yp_[0] = (bf16)y01; yp_[1024] = (bf16)(y01 >> 16); yp_[2048] = (bf16)y23; yp_[3072] = (bf16)(y23 >> 16); } \
            if ((n_) & 1) asm volatile("s_barrier" ::: "memory");   } while (0)
        for (int n = 0; n < NC; n += 2) { SP_STEP(C, N, n); SP_STEP(N, C, n + 1); }
#undef SP_STEP
    } else {
        for (int n = 0; n < NC / 2 + 1; ++n) SP_BAR();
    }
#undef SP_BAR
#undef SP_WAIT
    asm volatile("s_waitcnt vmcnt(0)" ::: "memory"); __syncthreads();
}

__device__ __forceinline__ void p3_gn_chunk(const Args& a, int ch, int lane) {
    const int n = lane & 15, rg = lane >> 4, head = ch & 15, c0 = head * 64 + 4 * n; const int t0 = (ch >> 4) * 16 + 4 * rg;
    const bf16* YR = (const bf16*)(a.ws + WS_YR); const bf16* ZB = (const bf16*)(a.ws + WS_ZB); bf16* Y = (bf16*)(a.ws + WS_XN); const float* RK = (const float*)(a.ws + WS_RK);
    const f32x4 lw = ld4(a.in[16] + c0), lb = ld4(a.in[17] + c0);
    f32x4 vimg[4];
#pragma unroll
    for (int cb = 0; cb < 4; ++cb) vimg[cb] = bf4(*(const v2u*)(a.ws + WS_VS + (size_t)ch * 2048 + cb * 512 + lane * 8));
#pragma unroll
    for (int e = 0; e < 4; ++e) { const int t = t0 + e;
        f32x4 y = bf4(*(const v2u*)(YR + (size_t)t * 1024 + c0));
        const f32x4 g = bf4(*(const v2u*)(ZB + (size_t)t * 5120 + 4096 + c0)); const float rk = RK[(size_t)t * 16 + head];
        const float mean = row16_sum((y.x + y.y) + (y.z + y.w)) * (1.f / 64.f);
        y = y - mean;
        const float rstd = __builtin_amdgcn_rsqf(row16_sum((y.x * y.x + y.y * y.y) + (y.z * y.z + y.w * y.w)) * (1.f / 64.f) + GN_EPS);
        const f32x4 v = {vimg[0][e], vimg[1][e], vimg[2][e], vimg[3][e]};
        f32x4 o = y * rstd * lw + lb + v * rk;
#pragma unroll
        for (int k = 0; k < 4; ++k) o[k] *= g[k] * __builtin_amdgcn_rcpf(1.f + __expf(-g[k]));
        *(v2u*)(Y + (size_t)t * 2048 + c0) = pk4(o); }
}
__device__ __forceinline__ void p5_row2(const Args& a, int rowA, int rowB, int lane) {
    const float* SSQ = (const float*)(a.ws + WS_SSQ);
    float sa = lane < 32 ? SSQ[(size_t)rowA * 32 + lane] : 0.f, sb = lane < 32 ? SSQ[(size_t)rowB * 32 + lane] : 0.f;
    const v2u* mbA = (const v2u*)((const bf16*)(a.ws + WS_MB) + (size_t)rowA * 2048) + lane; const v2u* mbB = (const v2u*)((const bf16*)(a.ws + WS_MB) + (size_t)rowB * 2048) + lane;
    const f32x4* xA = (const f32x4*)(a.in[0] + (size_t)rowA * 2048) + lane; const f32x4* xB = (const f32x4*)(a.in[0] + (size_t)rowB * 2048) + lane;
    const f32x4* g1 = (const f32x4*)a.in[22] + lane; const f32x4* g2 = (const f32x4*)a.in[23] + lane;
    f32x4 v[8], w[8]; v2u ma[8], mb_[8];
#pragma unroll
    for (int jj = 0; jj < 8; ++jj) { v[jj] = xA[64 * jj]; w[jj] = xB[64 * jj]; ma[jj] = mbA[64 * jj]; mb_[jj] = mbB[64 * jj]; }
#pragma unroll
    for (int o = 1; o < 64; o <<= 1) { sa += __shfl_xor(sa, o); sb += __shfl_xor(sb, o); }
    const float ra = 1.f / sqrtf(sa * (1.f / DMODEL) + RMS_EPS), rb = 1.f / sqrtf(sb * (1.f / DMODEL) + RMS_EPS);
    float s = 0.f, t = 0.f;
#pragma unroll
    for (int jj = 0; jj < 8; ++jj) { const f32x4 gg = g1[64 * jj]; v[jj] = v[jj] + bf4(ma[jj]) * ra * gg; w[jj] = w[jj] + bf4(mb_[jj]) * rb * gg;
        s += (v[jj].x * v[jj].x + v[jj].y * v[jj].y) + (v[jj].z * v[jj].z + v[jj].w * v[jj].w); t += (w[jj].x * w[jj].x + w[jj].y * w[jj].y) + (w[jj].z * w[jj].z + w[jj].w * w[jj].w); }
#pragma unroll
    for (int o = 1; o < 64; o <<= 1) { s += __shfl_xor(s, o); t += __shfl_xor(t, o); }
    const float r0 = 1.f / sqrtf(s * (1.f / DMODEL) + RMS_EPS), r1 = 1.f / sqrtf(t * (1.f / DMODEL) + RMS_EPS);
    f32x4* oA = (f32x4*)(a.out + (size_t)rowA * 2048) + lane; f32x4* oB = (f32x4*)(a.out + (size_t)rowB * 2048) + lane;
    v2u* nA = (v2u*)((bf16*)(a.ws + WS_XN) + (size_t)rowA * 2048) + lane; v2u* nB = (v2u*)((bf16*)(a.ws + WS_XN) + (size_t)rowB * 2048) + lane;
#pragma unroll
    for (int jj = 0; jj < 8; ++jj) { const f32x4 gg = g2[64 * jj]; oA[64 * jj] = v[jj]; oB[64 * jj] = w[jj]; nA[64 * jj] = pk4(v[jj] * r0 * gg); nB[64 * jj] = pk4(w[jj] * r1 * gg); }
}

__global__ void __launch_bounds__(NTHR, 2) hybrid_fwd(Args args) {
    extern __shared__ __attribute__((aligned(16))) unsigned char lds[];
    Frame F; F.lds = (LAS unsigned char*)lds; F.wave = __builtin_amdgcn_readfirstlane(threadIdx.x >> 6);
    F.G = gridDim.x; F.gw = blockIdx.x * NWAVES + F.wave; F.NGW = F.G * NWAVES;
    unsigned char* ws = args.ws;
    volatile LAS unsigned* MISC = (volatile LAS unsigned*)(F.lds + MISC_OFF);
    unsigned* ctl = (unsigned*)(ws + WS_CTL);
    { int l_ = lane_id(); if (F.wave == 0 && l_ < 32) MISC[l_] = 0u; }
    __syncthreads();
    cg::this_grid().sync();
    XcdBarrier bar;
    { int l_ = lane_id(); bar = xcd_barrier_post(ctl + 4096, MISC + 8, F.wave * 64 + l_); }
#define GRID_BAR() do { int l_ = lane_id(); asm volatile("" : "+v"(l_)); xcd_barrier(bar, F.wave * 64 + l_); } while (0)

    PHASE_BEGIN();
    p0_prologue(F, args);
    GRID_BAR();
    {   pg8::Gemm g{(const pg8::bf16_t*)(ws + WS_XN), (const pg8::bf16_t*)(ws + WS_WIN), M, NPAD, DMODEL}; pg8::StaticOrder S; S.init(M, NPAD, F.G, (int)blockIdx.x);
        pg8::EpiZ E{(pg8::bf16_t*)(ws + WS_ZA), (pg8::bf16_t*)(ws + WS_ZB), (float*)(ws + WS_ZS)};
        pg8::gemm_phase<pg8::EpiZ, pg8::StaticOrder, PG8_ALIGN, PG8_SP2>(F.lds, g, S, E, F.wave); }
    GRID_BAR();
    PHASE_BEGIN();
    for (int g = blockIdx.x; g < T / 64; g += F.G) p2a_fgroup(F, args, g);
    GRID_BAR();
    PHASE_BEGIN();
    {   for (int g = blockIdx.x; g < T / 64; g += F.G) p2b_fgroup(F, args, g);
        for (int m = F.gw; m < M; m += F.NGW) p2_qknorm_row(args, m, F.lane);
        for (int tile = blockIdx.x; tile < T / 32; tile += F.G) p2_rwprep_tile(F, args, tile * 32); }
    GRID_BAR();
    PHASE_BEGIN();
    {   if ((int)blockIdx.x < NRWB) p3_rwkv_state(F, args);
        const attn_body::bf16* ZBq = (const attn_body::bf16*)(ws + WS_ZB); attn_body::bf16* Yo = (attn_body::bf16*)(ws + WS_XN) + 1024; const float* F2 = (const float*)(ws + WS_F2);
        float gapB; { const float bq = fabsf(args.in[19][F.lane]), bk = fabsf(args.in[20][F.lane]); float mq = bq, mk = bk;
#pragma unroll
            for (int o = 1; o < 64; o <<= 1) { mq = fmaxf(mq, __shfl_xor(mq, o)); mk = fmaxf(mk, __shfl_xor(mk, o)); }
            const float gv_ = 2.f * (64.f * mq * mk * 0.125f * LOG2E * 1.03f) + 48.f; asm volatile("v_readfirstlane_b32 %0, %1" : "=s"(gapB) : "v"(gv_)); }
        for (;;) {
            if (F.wave == 0) {
                const int ln_ = lane_id(); unsigned uu = 0u; if (ln_ == 0) uu = atomicAdd(ctl + 64, 1u);
                uu = (unsigned)__builtin_amdgcn_readfirstlane((int)uu);
                int tsw = 0;
                if (uu < (unsigned)(NH * (T / 256))) { const int qb_ = (T / 256 - 1) - (int)(uu >> 4), h_ = (int)(uu & 15);
                    const unsigned* F2h = (const unsigned*)(F2 + (size_t)h_ * T); const float lim = __uint_as_float(__hip_atomic_load(F2h + qb_ * 256, __ATOMIC_RELAXED, __HIP_MEMORY_SCOPE_AGENT)) + gapB; const int ntf = 4 * qb_;
                    for (int i = 0; i < 4; ++i) { const int jt = ln_ + 64 * i; const bool c = (jt < ntf) && (__uint_as_float(__hip_atomic_load(F2h + 64 * jt + 63, __ATOMIC_RELAXED, __HIP_MEMORY_SCOPE_AGENT)) >= lim); tsw += __popcll(__ballot(c)); }
                    tsw &= ~1; }
                if (ln_ == 0) { MISC[0] = uu; MISC[1] = (unsigned)tsw; }
            }
            __syncthreads();
            const unsigned u = (unsigned)__builtin_amdgcn_readfirstlane((int)MISC[0]); const int ts = __builtin_amdgcn_readfirstlane((int)MISC[1]);
            __syncthreads();
            if (u >= (unsigned)(NH * (T / 256))) break;
            const int qb = (T / 256 - 1) - (int)(u >> 4), h = (int)(u & 15);
            attn_body::attn_unit<8>(h, qb, ZBq, ZBq + 1024, ZBq + 2048, ZBq + 3072, Yo, F2 + (size_t)h * T, (char*)lds, F.wave, ts);
        }
        if ((int)blockIdx.x >= NRWB) {
            __syncthreads();
            pg8::Gemm g{(const pg8::bf16_t*)(ws + WS_PB), (const pg8::bf16_t*)(ws + WS_WPLE), M, DMODEL, DPLE}; pg8::StaticOrder S; S.init(M, DMODEL, F.G - NRWB, (int)blockIdx.x - NRWB);
            pg8::EpiBf16<0> E{(pg8::bf16_t*)(ws + WS_PLE), DMODEL, nullptr, 0, 0, 1.f};
            pg8::gemm_phase<pg8::EpiBf16<0>, pg8::StaticOrder, PG8_ALIGN, PG8_SP2>(F.lds, g, S, E, F.wave); } }
    GRID_BAR();
    PHASE_BEGIN();
    for (int ch = F.gw; ch < (T / 16) * NH; ch += F.NGW) p3_gn_chunk(args, ch, F.lane);
    GRID_BAR();
    {   pg8::Gemm g{(const pg8::bf16_t*)(ws + WS_XN), (const pg8::bf16_t*)(ws + WS_WOUT), M, DMODEL, DMODEL}; pg8::StaticOrder S; S.init(M, DMODEL, F.G, (int)blockIdx.x);
        pg8::EpiM E{(pg8::bf16_t*)(ws + WS_MB), (float*)(ws + WS_SSQ)};
        pg8::gemm_phase<pg8::EpiM, pg8::StaticOrder, PG8_ALIGN, PG8_SP2>(F.lds, g, S, E, F.wave); }
    GRID_BAR();
    PHASE_BEGIN();
    for (int m = F.gw; m < M; m += 2 * F.NGW) p5_row2(args, m, m + F.NGW, F.lane);
    GRID_BAR();
    {   pg8::Gemm g{(const pg8::bf16_t*)(ws + WS_XN), (const pg8::bf16_t*)(ws + WS_WGATE), M, DMODEL, DMODEL}; pg8::StaticOrder S; S.init(M, DMODEL, F.G, (int)blockIdx.x);
        pg8::EpiFinal E{args.out, (const pg8::bf16_t*)(ws + WS_PLE)};
        pg8::gemm_phase<pg8::EpiFinal, pg8::StaticOrder, PG8_ALIGN, PG8_SP2>(F.lds, g, S, E, F.wave); }
}

extern "C" void kernel_launch(void* const* d_in, const int* in_sizes, int n_in, void* d_out, int out_size, void* d_ws, size_t ws_size, hipStream_t stream) {
    static int grid = 0;
    if (grid == 0) {
        if (n_in != 26 || in_sizes[0] != M * DMODEL || out_size != M * DMODEL || ws_size < WS_END) { fprintf(stderr, "kernel_launch: unexpected shapes (n_in %d, in0 %d, out %d, ws %zu)\n", n_in, n_in > 0 ? in_sizes[0] : -1, out_size, ws_size); grid = -1; return; }
        int dev = 0, cus = 0, per_cu = 0;
        if (hipGetDevice(&dev) != hipSuccess || hipDeviceGetAttribute(&cus, hipDeviceAttributeMultiprocessorCount, dev) != hipSuccess) { grid = -1; return; }
        if (hipFuncSetAttribute((const void*)hybrid_fwd, hipFuncAttributeMaxDynamicSharedMemorySize, LDS_BYTES) != hipSuccess) { fprintf(stderr, "kernel_launch: hipFuncSetAttribute failed\n"); grid = -1; return; }
        if (hipOccupancyMaxActiveBlocksPerMultiprocessor(&per_cu, (const void*)hybrid_fwd, NTHR, LDS_BYTES) != hipSuccess || per_cu < 1) { fprintf(stderr, "kernel_launch: occupancy query says %d\n", per_cu); (void)hipGetLastError(); grid = -1; return; }
        grid = cus * per_cu;
        if (grid < NRWB) { fprintf(stderr, "kernel_launch: grid %d too small\n", grid); grid = -1; return; }
    }
    if (grid < 0) return;
    (void)hipMemsetAsync((char*)d_ws + WS_CTL, 0, 65536, stream);
    Args a{};
    for (int i = 0; i < 26; ++i) a.in[i] = (const float*)d_in[i];
    a.out = (float*)d_out; a.ws = (unsigned char*)d_ws;
    void* kargs[] = {&a};
    hipError_t e = hipLaunchCooperativeKernel((const void*)hybrid_fwd, dim3(grid), dim3(NTHR), kargs, LDS_BYTES, stream);
    if (e != hipSuccess) fprintf(stderr, "kernel_launch: cooperative launch failed: %s (grid %d)\n", hipGetErrorString(e), grid);
}
```
